# Optimizing an MI355X kernel written in HIP

```python
import math
import jax, jax.numpy as jnp
from jax import lax
import numpy as np

D_MODEL = 1024
BATCH = 8
SEQ = 4096
DEPTH = 2
DEC_BATCH = 8
DEC_SEQ = 16
PAST_LEN = 1024

CHUNK = 64
N_EVEN = (DEPTH + 1) // 2
N_ODD = DEPTH // 2
N_HEADS = 8
N_KV_HEADS = 2
Q_PER_KV = N_HEADS // N_KV_HEADS
HEAD_DIM = 64
ATTN_WIDTH = N_HEADS * HEAD_DIM
KV_WIDTH = N_KV_HEADS * HEAD_DIM
WINDOW = 128
WINDOW_CHUNKS = WINDOW // CHUNK
N_BUCKETS = 32
MAX_DISTANCE = 128
CONV_WIDTH = D_MODEL // 2
CONV_K = 3
IN_WIDTH = ATTN_WIDTH + 2 * KV_WIDTH + 3 * CONV_WIDTH
MIX_WIDTH = ATTN_WIDTH + CONV_WIDTH
SPLIT_POINTS = (ATTN_WIDTH, ATTN_WIDTH + KV_WIDTH, ATTN_WIDTH + 2 * KV_WIDTH,
                ATTN_WIDTH + 2 * KV_WIDTH + CONV_WIDTH, ATTN_WIDTH + 2 * KV_WIDTH + 2 * CONV_WIDTH)
POOL_SIZES = (2, 4, 8, 16)
POOL_GROUPS = len(POOL_SIZES)
POOL_GROUP = D_MODEL // POOL_GROUPS
POOL_MAX = max(POOL_SIZES)
D_FF = 2816
EPS = 1e-6
NEG = -1e30

kernel_name = "hybrid_streaming_encoder_step"


def rms_norm(x, g):
    xf = x.astype(jnp.float32)
    y = xf * lax.rsqrt(jnp.mean(xf * xf, axis=-1, keepdims=True) + EPS)
    return (y * g.astype(jnp.float32)).astype(x.dtype)


def swiglu(h, w_gate, w_up, w_down):
    return (jax.nn.silu(h @ w_gate) * (h @ w_up)) @ w_down


def rel_bucket(rel):
    half = N_BUCKETS // 2
    ret = jnp.where(rel > 0, half, 0)
    n = jnp.abs(rel)
    max_exact = half // 2
    nf = jnp.maximum(n, 1).astype(jnp.float32)
    large = max_exact + (jnp.log(nf / max_exact) / math.log(MAX_DISTANCE / max_exact)
                         * (half - max_exact)).astype(jnp.int32)
    large = jnp.minimum(large, half - 1)
    return ret + jnp.where(n < max_exact, n, large)


def rel_bias(q_pos, k_pos, table):
    b = rel_bucket(k_pos[None, :] - q_pos[:, None])
    bias = jnp.take(table, b, axis=0).astype(jnp.float32)
    return jnp.transpose(bias, (2, 0, 1)).reshape(N_KV_HEADS, Q_PER_KV, q_pos.shape[0], k_pos.shape[0])


def attend(q, k, v, bias, key_valid, sinks):
    s = jnp.einsum('bnqhgd,bnkhd->bnhgqk', q, k).astype(jnp.float32) * (HEAD_DIM ** -0.5) + bias
    if key_valid is not None:
        s = jnp.where(key_valid[None, :, None, None, None, :], s, NEG)
    sink = sinks.astype(jnp.float32).reshape(N_KV_HEADS, Q_PER_KV)[:, :, None, None]
    m = jnp.maximum(jnp.max(s, axis=-1, keepdims=True), sink)
    p = jnp.exp(s - m)
    w = p / (jnp.sum(p, axis=-1, keepdims=True) + jnp.exp(sink - m))
    return jnp.einsum('bnhgqk,bnkhd->bnqhgd', w.astype(v.dtype), v)


def attn_prompt(q, k, v, sinks, table):
    B, S = q.shape[:2]
    nc = S // CHUNK
    kb_len = WINDOW + CHUNK
    qb = q.reshape(B, nc, CHUNK, N_KV_HEADS, Q_PER_KV, HEAD_DIM)

    def band(t):
        tp = jnp.pad(t, ((0, 0), (WINDOW, 0), (0, 0), (0, 0)))
        tp = tp.reshape(B, nc + WINDOW_CHUNKS, CHUNK, N_KV_HEADS, HEAD_DIM)
        return jnp.concatenate([tp[:, j:j + nc] for j in range(WINDOW_CHUNKS + 1)], axis=2)

    offs = jnp.arange(kb_len) - WINDOW
    bias = rel_bias(jnp.arange(CHUNK), offs, table)
    k_pos = jnp.arange(nc)[:, None] * CHUNK + offs[None, :]
    out = attend(qb, band(k), band(v), bias, k_pos >= 0, sinks)
    return out.reshape(B, S, ATTN_WIDTH)


def attn_sample(q, k, v, ck, cv, t0, sinks, table):
    B, T = q.shape[:2]
    kk = jnp.concatenate([ck, k], axis=1)
    vv = jnp.concatenate([cv, v], axis=1)
    q_pos = t0 + jnp.arange(T)
    k_pos = t0 - ck.shape[1] + jnp.arange(kk.shape[1])
    bias = rel_bias(q_pos, k_pos, table)
    out = attend(q[:, None], kk[:, None], vv[:, None], bias, None, sinks)
    return out.reshape(B, T, ATTN_WIDTH)


def short_conv(u, hist, w):
    T = u.shape[1]
    up = jnp.concatenate([hist, u], axis=1)
    y = sum(w[j] * up[:, j:j + T] for j in range(CONV_K))
    return y, up[:, -(CONV_K - 1):]


def pool_mix(h, hist, t0, w_pool, scale):
    B, T, _ = h.shape
    lh = hist.shape[1]
    hp = jnp.concatenate([hist, h], axis=1)
    cs = jnp.pad(jnp.cumsum(hp.astype(jnp.float32), axis=1), ((0, 0), (1, 0), (0, 0)))
    t = jnp.arange(T)
    end = lh + 1 + t
    hf = h.astype(jnp.float32)
    diffs = []
    for g, w in enumerate(POOL_SIZES):
        sl = slice(g * POOL_GROUP, (g + 1) * POOL_GROUP)
        cnt = jnp.minimum(t0 + t + 1, w)
        csg = cs[..., sl]
        mean = (jnp.take(csg, end, axis=1) - jnp.take(csg, end - cnt, axis=1)) / cnt[:, None].astype(jnp.float32)
        diffs.append(mean - hf[..., sl])
    d = jnp.stack(diffs, axis=2).astype(h.dtype)
    y = jnp.einsum('btgc,gce->btge', d, w_pool).reshape(B, T, D_MODEL) * scale
    return y, hp[:, -(POOL_MAX - 1):]


def trunk(x, cache_k, cache_v, cache_conv, cache_pool, t0, norm_g, ffn_w_gate, ffn_w_up, ffn_w_down,
          mix_w_in, mix_w_out, conv_w, attn_sinks, rel_bias_table, pool_w, pool_scale, final_norm_g):
    first = cache_k is None
    B, T = x.shape[:2]
    new_k, new_v, new_conv, new_pool = [], [], [], []
    for layer in range(DEPTH):
        x = x + 0.5 * swiglu(rms_norm(x, norm_g[layer, 0]), ffn_w_gate[layer, 0], ffn_w_up[layer, 0], ffn_w_down[layer, 0])
        h = rms_norm(x, norm_g[layer, 1])
        if layer % 2 == 0:
            e = layer // 2
            q, k, v, bg, cg, xi = jnp.split(h @ mix_w_in[e], SPLIT_POINTS, axis=-1)
            q = q.reshape(B, T, N_KV_HEADS, Q_PER_KV, HEAD_DIM)
            k = k.reshape(B, T, N_KV_HEADS, HEAD_DIM)
            v = v.reshape(B, T, N_KV_HEADS, HEAD_DIM)
            if first:
                a = attn_prompt(q, k, v, attn_sinks[e], rel_bias_table)
                keep = min(WINDOW, T)
                new_k.append(k[:, -keep:])
                new_v.append(v[:, -keep:])
                hist = jnp.zeros((B, CONV_K - 1, CONV_WIDTH), h.dtype)
            else:
                a = attn_sample(q, k, v, cache_k[e], cache_v[e], t0, attn_sinks[e], rel_bias_table)
                new_k.append(k)
                new_v.append(v)
                hist = cache_conv[e]
            c, conv_state = short_conv(cg * xi, hist, conv_w[e])
            new_conv.append(conv_state)
            x = x + jnp.concatenate([a, bg * c], axis=-1) @ mix_w_out[e]
        else:
            o = layer // 2
            hist = jnp.zeros((B, 0, D_MODEL), h.dtype) if first else cache_pool[o]
            p, pool_state = pool_mix(h, hist, t0, pool_w[o], pool_scale[o])
            new_pool.append(pool_state)
            x = x + p
        x = x + 0.5 * swiglu(rms_norm(x, norm_g[layer, 2]), ffn_w_gate[layer, 1], ffn_w_up[layer, 1], ffn_w_down[layer, 1])
    return (rms_norm(x, final_norm_g), jnp.stack(new_k), jnp.stack(new_v), jnp.stack(new_conv), jnp.stack(new_pool))


def setup_inputs(seed: int = 0) -> dict:
    key = jax.random.key(seed)
    ks = jax.random.split(key, 20)
    f32 = jnp.float32

    def nrm(k, shape, s):
        return s * jax.random.normal(k, shape, f32)

    lc = min(WINDOW, PAST_LEN)
    return {
        "x_prompt": nrm(ks[0], (BATCH, SEQ, D_MODEL), 1.0),
        "x_sample": nrm(ks[1], (DEC_BATCH, DEC_SEQ, D_MODEL), 1.0),
        "cache_attn_k": nrm(ks[2], (N_EVEN, DEC_BATCH, lc, N_KV_HEADS, HEAD_DIM), 1.0),
        "cache_attn_v": nrm(ks[3], (N_EVEN, DEC_BATCH, lc, N_KV_HEADS, HEAD_DIM), 1.0),
        "cache_conv": nrm(ks[4], (N_EVEN, DEC_BATCH, CONV_K - 1, CONV_WIDTH), 1.0),
        "cache_pool": nrm(ks[5], (N_ODD, DEC_BATCH, POOL_MAX - 1, D_MODEL), 1.0),
        "norm_g": 1.0 + nrm(ks[6], (DEPTH, 3, D_MODEL), 0.05),
        "ffn_w_gate": nrm(ks[7], (DEPTH, 2, D_MODEL, D_FF), D_MODEL ** -0.5),
        "ffn_w_up": nrm(ks[8], (DEPTH, 2, D_MODEL, D_FF), D_MODEL ** -0.5),
        "ffn_w_down": nrm(ks[9], (DEPTH, 2, D_FF, D_MODEL), D_FF ** -0.5),
        "mix_w_in": nrm(ks[10], (N_EVEN, D_MODEL, IN_WIDTH), D_MODEL ** -0.5),
        "mix_w_out": nrm(ks[11], (N_EVEN, MIX_WIDTH, D_MODEL), MIX_WIDTH ** -0.5),
        "conv_w": nrm(ks[12], (N_EVEN, CONV_K, CONV_WIDTH), CONV_K ** -0.5),
        "attn_sinks": nrm(ks[13], (N_EVEN, N_HEADS), 0.5),
        "rel_bias_table": nrm(ks[14], (N_BUCKETS, N_HEADS), 0.5),
        "pool_w": nrm(ks[15], (N_ODD, POOL_GROUPS, POOL_GROUP, POOL_GROUP), POOL_GROUP ** -0.5),
        "pool_scale": 1.0 + nrm(ks[16], (N_ODD, D_MODEL), 0.1),
        "final_norm_g": 1.0 + nrm(ks[17], (D_MODEL,), 0.05),
    }


def reference(x_prompt, x_sample, cache_attn_k, cache_attn_v, cache_conv, cache_pool, norm_g, ffn_w_gate, ffn_w_up,
              ffn_w_down, mix_w_in, mix_w_out, conv_w, attn_sinks, rel_bias_table, pool_w, pool_scale, final_norm_g):
    y_prompt, k_p, v_p, conv_p, pool_p = trunk(
        x_prompt, None, None, None, None, 0, norm_g, ffn_w_gate, ffn_w_up, ffn_w_down,
        mix_w_in, mix_w_out, conv_w, attn_sinks, rel_bias_table, pool_w, pool_scale, final_norm_g)
    y_sample, k_s, v_s, conv_s, pool_s = trunk(
        x_sample, cache_attn_k, cache_attn_v, cache_conv, cache_pool, PAST_LEN, norm_g, ffn_w_gate, ffn_w_up, ffn_w_down,
        mix_w_in, mix_w_out, conv_w, attn_sinks, rel_bias_table, pool_w, pool_scale, final_norm_g)
    return (y_prompt, y_sample, k_p, v_p, conv_p, pool_p, k_s, v_s, conv_s, pool_s)
```

```cpp
#include <hip/hip_runtime.h>
#include <hip/hip_cooperative_groups.h>
#include <cstdio>
namespace cg = cooperative_groups;

#ifndef PROBE_DUP
#define PROBE_DUP 0
#endif
#ifndef PROBE_K2
#define PROBE_K2 0
#endif
#ifndef PROBE_EPI2
#define PROBE_EPI2 0
#endif
#ifndef PROBE_SYNC
#define PROBE_SYNC 0
#endif
#ifndef MK_MULTI
#define MK_MULTI 0
#endif

#define LAS __attribute__((address_space(3)))
typedef unsigned short bf16_t;
typedef short bf16x8 __attribute__((ext_vector_type(8)));
typedef float f32x4 __attribute__((ext_vector_type(4)));
typedef unsigned u32x4 __attribute__((ext_vector_type(4)));
typedef unsigned u32x2 __attribute__((ext_vector_type(2)));

constexpr int DM = 1024, SEQL = 4096, NP = 32768, NS = 128, NR = NP + NS, DFF = 2816;
constexpr int NPH = 15;
constexpr int LDS_BYTES = 131072 + 1024;
constexpr size_t O_YP = 0, O_YS = 33554432, O_KP = O_YS + 131072, O_VP = O_KP + 131072, O_CONVP = O_VP + 131072, O_POOLP = O_CONVP + 8192,
                 O_KS = O_POOLP + 122880, O_VS = O_KS + 16384, O_CONVS = O_VS + 16384, O_POOLS = O_CONVS + 8192;
constexpr size_t WS_X = 0;
constexpr size_t WS_XB = WS_X + (size_t)NR * DM * 4;
constexpr size_t WS_ACT = WS_XB + (size_t)NR * DM * 2;
constexpr size_t WS_Q = WS_ACT;
constexpr size_t WS_KB = WS_Q + (size_t)NR * 512 * 2;
constexpr size_t WS_VB = WS_KB + (size_t)NR * 128 * 2;
constexpr size_t WS_BG = WS_VB + (size_t)NR * 128 * 2;
constexpr size_t WS_U = WS_BG + (size_t)NR * 512 * 2;
constexpr size_t WS_MIX = WS_U + (size_t)NR * 512 * 2;
constexpr size_t WS_SS = WS_ACT + (size_t)NR * DFF * 2;
constexpr size_t WS_WGU = WS_SS + (size_t)NR * 16 * 4;
constexpr size_t WS_WD = WS_WGU + (size_t)4 * 5632 * 1024 * 2;
constexpr size_t WS_WIN = WS_WD + (size_t)4 * 1024 * 2816 * 2;
constexpr size_t WS_WOUT = WS_WIN + (size_t)2304 * 1024 * 2;
constexpr size_t WS_WP = WS_WOUT + (size_t)1024 * 1024 * 2;
constexpr size_t WS_BAR = WS_WP + (size_t)1024 * 256 * 2;
constexpr size_t WS_END = WS_BAR + 17 * 256;
static_assert(WS_MIX + (size_t)NR * 1024 * 2 == WS_SS, "mixer buffers alias ACT exactly");

struct Params {
    const float *x_prompt, *x_sample, *cache_k, *cache_v, *cache_conv, *cache_pool, *norm_g, *w_gate, *w_up, *w_down, *mix_w_in, *mix_w_out, *conv_w, *sinks, *rel_table, *pool_w, *pool_scale, *final_g;
    float* out; unsigned char* ws; int ph_lo, ph_hi;
};

__device__ __forceinline__ int bidx() { int b = (int)blockIdx.x; asm volatile("" : "+s"(b)); return b; }
typedef float f32x2_t __attribute__((ext_vector_type(2)));
typedef __bf16 bf16x2_t __attribute__((ext_vector_type(2)));
__device__ __forceinline__ unsigned cvt_pk_bf16(float lo, float hi) { const f32x2_t v = {lo, hi}; const bf16x2_t b = __builtin_convertvector(v, bf16x2_t); return __builtin_bit_cast(unsigned, b); }
__device__ __forceinline__ u32x2 pack4(f32x4 v) { u32x2 w; w.x = cvt_pk_bf16(v[0], v[1]); w.y = cvt_pk_bf16(v[2], v[3]); return w; }
__device__ __forceinline__ float bf_lo(unsigned w) { return __uint_as_float(w << 16); }
__device__ __forceinline__ float bf_hi(unsigned w) { return __uint_as_float(w & 0xffff0000u); }
__device__ __forceinline__ float row_rs(const float* SS, int row) {
    const f32x4* p = (const f32x4*)(SS + (size_t)row * 16); const f32x4 a = p[0], b = p[1], c = p[2], d = p[3];
    const f32x4 s = (a + b) + (c + d); const float t = (s[0] + s[1]) + (s[2] + s[3]);
    return __builtin_amdgcn_rsqf(t * (1.0f / 1024.0f) + 1e-6f);
}

namespace pg8 {
constexpr int BM = 256, BK = 64, HALF = 128, HTB = HALF * BK * 2, NXCD = 8, WGM = 8;
__device__ __forceinline__ int lds_byte(int r, int c) { const int st = (r >> 4) * 2 + (c >> 5), rr = r & 15, cc = c & 31, ob = rr * 64 + cc * 2; return st * 1024 + (ob ^ (((ob >> 9) & 1) << 5)); }
__device__ __forceinline__ void stage_rc(int b, int& R, int& C) { const int st = b / 1024, sb = b % 1024, swz = sb ^ (((sb >> 9) & 1) << 5); R = (st >> 1) * 16 + swz / 64; C = (st & 1) * 32 + (swz % 64) / 2; }
struct Unit { int pm, pn; };
struct Gemm { const bf16_t* A; const bf16_t* Bt; int nM, nN, K, lda, ldb, apn; };
struct StaticOrder {
    int nM, nN, nwg, G, c;
    __device__ void init(int nM_, int nN_, int G_, int c_) { nM = nM_; nN = nN_; nwg = nM * nN; G = G_; c = c_; }
    __device__ bool next(int i, Unit& u) const {
        const long L = (long)i * G + c; if (L >= nwg) return false;
        if (nM == 128) {
            const int xcd = (int)L & 7, off = (int)L >> 3, nig8 = 8 * nN, hi = off >= nig8, rem = off - (hi ? nig8 : 0);
            u.pm = (2 * xcd + hi) * 8 + (rem & 7); u.pn = rem >> 3; return true;
        }
        int wgid = (int)L; { const int q = nwg / NXCD, r = nwg % NXCD, xcd = wgid % NXCD, off = wgid / NXCD; wgid = (xcd < r ? xcd * (q + 1) : r * (q + 1) + (xcd - r) * q) + off; }
        const int nig = WGM * nN, gid = wgid / nig, fm = gid * WGM, gsz = (nM - fm) < WGM ? (nM - fm) : WGM;
        u.pm = fm + ((wgid % nig) % gsz); u.pn = (wgid % nig) / gsz; return true;
    }
};

template <class Epi>
__device__ __forceinline__ void gemm_phase(const int tid, LAS unsigned char* lds, const Gemm g, const StaticOrder& S, const Epi& E) {
    const int wid = __builtin_amdgcn_readfirstlane(tid >> 6), lane = tid & 63, wr = wid >> 2, wc = wid & 3, fr = lane & 15, fq = lane >> 4;
    const int K = g.K, nt = K / BK;
    unsigned voffA[2], voffB[2];
#pragma unroll
    for (int i = 0; i < 2; ++i) { int R, C; stage_rc(tid * 16 + i * 8192, R, C); voffA[i] = (unsigned)(R * g.lda + C) * 2u; voffB[i] = (unsigned)(R * g.ldb + C) * 2u; }
    const size_t kstep = (size_t)(BK * 2);
    const size_t hA = (size_t)HALF * g.lda * 2, hB = (size_t)HALF * g.ldb * 2;
    const unsigned ldsw = (unsigned)wid * 1024u;
    const int aoff = lds_byte(wr * 64 + fr, fq * 8), boff = lds_byte(wc * 32 + fr, fq * 8);
#define PG8_SA(b, h) (((b) * 2 + (h)) * HTB)
#define PG8_SB(b, h) ((4 + (b) * 2 + (h)) * HTB)
#define PG8_STAGE(bufoff, gbase, voff) do { _Pragma("unroll") for (int _i = 0; _i < 2; ++_i) \
        __builtin_amdgcn_global_load_lds((const unsigned*)((const char*)(gbase) + (voff)[_i]), (LAS unsigned*)(lds + (bufoff) + ldsw + _i * 8192), 16, 0, 0); } while (0)
#define PG8_LDA(dst, b, h) do { _Pragma("unroll") for (int m = 0; m < 4; ++m) _Pragma("unroll") for (int k = 0; k < 2; ++k) dst[m][k] = *(const LAS bf16x8*)(lds + PG8_SA(b, h) + aoff + m * 2048 + k * 1024); } while (0)
#define PG8_LDB(dst, b, h) do { _Pragma("unroll") for (int n = 0; n < 2; ++n) _Pragma("unroll") for (int k = 0; k < 2; ++k) dst[n][k] = *(const LAS bf16x8*)(lds + PG8_SB(b, h) + boff + n * 2048 + k * 1024); } while (0)
#define PG8_MMA(ai, bj, At, Bt) do { __builtin_amdgcn_s_setprio(1); _Pragma("unroll") for (int m = 0; m < 4; ++m) _Pragma("unroll") for (int n = 0; n < 2; ++n) _Pragma("unroll") for (int k = 0; k < 2; ++k) \
        acc[ai][bj][m][n] = __builtin_amdgcn_mfma_f32_16x16x32_bf16(Bt[n][k], At[m][k], acc[ai][bj][m][n], 0, 0, 0); __builtin_amdgcn_s_setprio(0); } while (0)
#define PG8_WAIT_V(n) asm volatile("s_waitcnt vmcnt(" #n ")" ::: "memory")
#define PG8_WAIT_L(n) asm volatile("s_waitcnt lgkmcnt(" #n ")" ::: "memory")
#define PG8_BAR __builtin_amdgcn_s_barrier()
#define PG8_SCHED __builtin_amdgcn_sched_barrier(0)
    Unit cur, nxt; int ui = 0, last_pm = -1; LAS float* rsl = (LAS float*)(lds + 131072);
    if (!S.next(0, cur)) return;
    f32x4 acc[2][2][4][2];
#pragma unroll
    for (int a = 0; a < 2; ++a)
#pragma unroll
        for (int b = 0; b < 2; ++b)
#pragma unroll
            for (int m = 0; m < 4; ++m)
#pragma unroll
                for (int n = 0; n < 2; ++n) acc[a][b][m][n] = (f32x4){0.f, 0.f, 0.f, 0.f};
    bf16x8 At[4][2], B0[2][2], B1[2][2];
    const char* cA = (const char*)g.A + ((size_t)cur.pm * 256 * g.lda + (size_t)cur.pn * g.apn) * 2; const char* cB = (const char*)g.Bt + (size_t)cur.pn * 256 * g.ldb * 2;
    PG8_STAGE(PG8_SB(0, 0), cB, voffB); PG8_STAGE(PG8_SA(0, 0), cA, voffA); PG8_STAGE(PG8_SB(0, 1), cB + hB, voffB); PG8_STAGE(PG8_SA(0, 1), cA + hA, voffA);
    if (wr == 1) PG8_BAR;
    PG8_WAIT_V(4); PG8_BAR;
    PG8_STAGE(PG8_SB(1, 0), cB + kstep, voffB); PG8_STAGE(PG8_SA(1, 0), cA + kstep, voffA); PG8_STAGE(PG8_SB(1, 1), cB + hB + kstep, voffB);
    PG8_WAIT_V(6); PG8_BAR;
    for (;;) {
        const bool has_next = S.next(PROBE_K2 ? ((ui + 1) >> 1) : (ui + 1), nxt);
        const char* nA = has_next ? (const char*)g.A + ((size_t)nxt.pm * 256 * g.lda + (size_t)nxt.pn * g.apn) * 2 : cA; const char* nB = has_next ? (const char*)g.Bt + (size_t)nxt.pn * 256 * g.ldb * 2 : cB;
        for (int t = 0; t < nt; t += 2) {
            const bool last = (t == nt - 2);
            const char* a1 = cA + (size_t)(t + 1) * kstep;
            const char* a2 = last ? nA : cA + (size_t)(t + 2) * kstep; const char* b2 = last ? nB : cB + (size_t)(t + 2) * kstep;
            const char* a3 = a2 + kstep; const char* b3 = b2 + kstep;
            PG8_LDB(B0, 0, 0); PG8_SCHED; PG8_LDA(At, 0, 0); PG8_STAGE(PG8_SA(1, 1), a1 + hA, voffA);
            PG8_WAIT_L(8); PG8_BAR; PG8_WAIT_L(0); PG8_MMA(0, 0, At, B0); PG8_BAR; PG8_SCHED;
            PG8_LDB(B1, 0, 1); PG8_STAGE(PG8_SB(0, 0), b2, voffB);
            PG8_BAR; PG8_WAIT_L(0); PG8_MMA(0, 1, At, B1); PG8_BAR;
            PG8_LDA(At, 0, 1); PG8_STAGE(PG8_SA(0, 0), a2, voffA);
            PG8_BAR; PG8_WAIT_L(0); PG8_MMA(1, 0, At, B0); PG8_BAR; PG8_SCHED;
            PG8_STAGE(PG8_SB(0, 1), b2 + hB, voffB);
            PG8_WAIT_V(6); PG8_BAR; PG8_MMA(1, 1, At, B1); PG8_BAR;
            PG8_LDB(B0, 1, 0); PG8_SCHED; PG8_LDA(At, 1, 0); PG8_STAGE(PG8_SA(0, 1), a2 + hA, voffA);
            PG8_WAIT_L(8); PG8_BAR; PG8_WAIT_L(0); PG8_MMA(0, 0, At, B0); PG8_BAR; PG8_SCHED;
            PG8_LDB(B1, 1, 1); PG8_STAGE(PG8_SB(1, 0), b3, voffB);
            PG8_BAR; PG8_WAIT_L(0); PG8_MMA(0, 1, At, B1); PG8_BAR;
            PG8_LDA(At, 1, 1); PG8_STAGE(PG8_SA(1, 0), a3, voffA);
            PG8_BAR; PG8_WAIT_L(0); PG8_MMA(1, 0, At, B0); PG8_BAR; PG8_SCHED;
            PG8_STAGE(PG8_SB(1, 1), b3 + hB, voffB);
            PG8_WAIT_V(6); PG8_BAR; PG8_MMA(1, 1, At, B1); PG8_BAR;
        }
        if (!PROBE_K2 || (ui & 1)) {
        if constexpr (Epi::NEEDS_RS) {
            if (cur.pm != last_pm) { last_pm = cur.pm;
                if (tid < 256) rsl[tid] = row_rs(E.SS, cur.pm * 256 + tid);
                PG8_WAIT_L(0); PG8_BAR; }
        }
        E(acc, cur, wr, wc, fr, fq, rsl);
        if constexpr (PROBE_EPI2 && Epi::NEEDS_RS) { asm volatile("" ::: "memory"); E(acc, cur, wr, wc, fr, fq, rsl); }
        }
        if (!has_next) break;
#pragma unroll
        for (int a = 0; a < 2; ++a)
#pragma unroll
            for (int b = 0; b < 2; ++b)
#pragma unroll
                for (int m = 0; m < 4; ++m)
#pragma unroll
                    for (int n = 0; n < 2; ++n) acc[a][b][m][n] = (f32x4){0.f, 0.f, 0.f, 0.f};
        cur = nxt; cA = nA; cB = nB; ++ui;
    }
    PG8_WAIT_V(0);
    if (wr == 0) PG8_BAR;
    PG8_BAR;
#undef PG8_SA
#undef PG8_SB
#undef PG8_STAGE
#undef PG8_LDA
#undef PG8_LDB
#undef PG8_MMA
#undef PG8_WAIT_V
#undef PG8_WAIT_L
#undef PG8_BAR
#undef PG8_SCHED
}
}

struct EpiSwiglu {
    static constexpr bool NEEDS_RS = true;
    const float* SS; bf16_t* ACT;
    __device__ __forceinline__ f32x4 act4(float rs, f32x4 g, f32x4 u) const {
        f32x4 a;
#pragma unroll
        for (int j = 0; j < 4; ++j) { const float gg = g[j] * rs, uu = u[j] * rs; a[j] = gg * __builtin_amdgcn_rcpf(1.0f + __expf(-gg)) * uu; }
        return a;
    }
    __device__ __forceinline__ void operator()(const f32x4 (&acc)[2][2][4][2], const pg8::Unit& u, int wr, int wc, int fr, int fq, const LAS float* rsl) const {
#pragma unroll
        for (int ai = 0; ai < 2; ++ai)
#pragma unroll
            for (int m = 0; m < 4; ++m) { const int lr = ai * 128 + wr * 64 + m * 16 + fr, row = u.pm * 256 + lr; const float rs = rsl[lr];
                const u32x2 lo = pack4(act4(rs, acc[ai][0][m][0], acc[ai][0][m][1])), hi = pack4(act4(rs, acc[ai][1][m][0], acc[ai][1][m][1]));
                *(u32x4*)(ACT + (size_t)row * DFF + u.pn * 128 + wc * 32 + 8 * fq) = (u32x4){lo.x, lo.y, hi.x, hi.y}; }
    }
    __device__ __forceinline__ void wtile(int row, int colbase, int fq, const f32x4 (&v)[2]) const {
        const int r = 128 * (colbase >> 8) + 32 * ((colbase >> 5) & 3) + 8 * fq + 4 * ((colbase >> 7) & 1);
        *(u32x2*)(ACT + (size_t)row * DFF + r) = pack4(act4(row_rs(SS, row), v[0], v[1]));
    }
};

__device__ __forceinline__ f32x4 unpack4(u32x2 w) { return (f32x4){bf_lo(w.x), bf_hi(w.x), bf_lo(w.y), bf_hi(w.y)}; }
struct EpiResid {
    static constexpr bool NEEDS_RS = false;
    bf16_t* XB; float* SS;
    __device__ __forceinline__ float oct(int row, int col, u32x4 r, f32x4 a0, f32x4 a1) const {
        const f32x4 x0 = unpack4((u32x2){r.x, r.y}) + a0, x1 = unpack4((u32x2){r.z, r.w}) + a1; const u32x2 p0 = pack4(x0), p1 = pack4(x1);
        *(u32x4*)(XB + (size_t)row * DM + col) = (u32x4){p0.x, p0.y, p1.x, p1.y};
        return ((x0[0] * x0[0] + x0[1] * x0[1]) + (x0[2] * x0[2] + x0[3] * x0[3])) + ((x1[0] * x1[0] + x1[1] * x1[1]) + (x1[2] * x1[2] + x1[3] * x1[3]));
    }
    __device__ __forceinline__ void ldres(u32x4 (&r)[2], const pg8::Unit& u, int g, int wr, int wc, int fr, int fq) const {
        const bf16_t* rp = XB + (size_t)(u.pm * 256 + (g >> 2) * 128 + wr * 64 + (g & 3) * 16 + fr) * DM + u.pn * 256 + wc * 32 + 8 * fq;
#pragma unroll
        for (int bj = 0; bj < 2; ++bj) r[bj] = *(const u32x4*)(rp + bj * 128);
    }
    __device__ __forceinline__ void operator()(const f32x4 (&acc)[2][2][4][2], const pg8::Unit& u, int wr, int wc, int fr, int fq, const LAS float*) const {
        u32x4 r[8][2];
#pragma unroll
        for (int g = 0; g < 6; ++g) ldres(r[g], u, g, wr, wc, fr, fq);
#pragma unroll
        for (int g = 0; g < 8; ++g) { const int ai = g >> 2, m = g & 3, row = u.pm * 256 + ai * 128 + wr * 64 + m * 16 + fr; float ss = 0.f;
#pragma unroll
            for (int bj = 0; bj < 2; ++bj) ss += oct(row, u.pn * 256 + bj * 128 + wc * 32 + 8 * fq, r[g][bj], acc[ai][bj][m][0], acc[ai][bj][m][1]);
            ss += __shfl_xor(ss, 16); ss += __shfl_xor(ss, 32);
            if (fq == 0) SS[(size_t)row * 16 + u.pn * 4 + wc] = ss;
            if (g + 6 < 8) ldres(r[g + 6], u, g + 6, wr, wc, fr, fq); }
    }
    __device__ __forceinline__ void wtile(int row, int colbase, int fq, const f32x4 (&v)[4]) const {
        const bf16_t* rp = XB + (size_t)row * DM + colbase + 8 * fq; u32x4 r[2];
#pragma unroll
        for (int h = 0; h < 2; ++h) r[h] = *(const u32x4*)(rp + 32 * h);
        float ss = oct(row, colbase + 8 * fq, r[0], v[0], v[1]) + oct(row, colbase + 32 + 8 * fq, r[1], v[2], v[3]);
        ss += __shfl_xor(ss, 16); ss += __shfl_xor(ss, 32);
        if (fq == 0) SS[(size_t)row * 16 + (colbase >> 6)] = ss;
    }
};

struct EpiMixIn {
    static constexpr bool NEEDS_RS = true;
    const float* SS; bf16_t *Q, *KB, *VB, *BG, *U; float* out;
    __device__ __forceinline__ void tile2(int row, int colbase, int fq, float rs, f32x4 v0, f32x4 v1) const {
        v0 = v0 * rs; v1 = v1 * rs;
        int b, s; const bool smp = row >= NP;
        if (!smp) { b = row >> 12; s = row & 4095; } else { b = (row - NP) >> 4; s = (row - NP) & 15; }
        if (colbase >= 1280) {
            const int c = ((colbase - 1280) >> 1) + 4 * fq; const f32x4 uu = v0 * v1;
            *(u32x2*)(U + (size_t)row * 512 + c) = pack4(uu);
            if (!smp) { if (s >= SEQL - 2) *(f32x4*)(out + O_CONVP + (size_t)(b * 2 + s - (SEQL - 2)) * 512 + c) = uu; }
            else { if (s >= 14) *(f32x4*)(out + O_CONVS + (size_t)(b * 2 + s - 14) * 512 + c) = uu; }
        } else {
#pragma unroll
            for (int q = 0; q < 2; ++q) { const int col = colbase + 16 * q + 4 * fq; const f32x4 v = q ? v1 : v0; const u32x2 w = pack4(v);
                if (colbase < 512) *(u32x2*)(Q + (size_t)row * 512 + col) = w;
                else if (colbase < 768) {
                    const bool isk = colbase < 640; const int c = col - (isk ? 512 : 640);
                    *(u32x2*)((isk ? KB : VB) + (size_t)row * 128 + c) = w;
                    if (!smp) { if (s >= SEQL - 128) *(f32x4*)(out + (isk ? O_KP : O_VP) + (size_t)(b * 128 + s - (SEQL - 128)) * 128 + c) = v; }
                    else *(f32x4*)(out + (isk ? O_KS : O_VS) + (size_t)(row - NP) * 128 + c) = v;
                } else *(u32x2*)(BG + (size_t)row * 512 + col - 768) = w; }
        }
    }
    __device__ __forceinline__ void operator()(const f32x4 (&acc)[2][2][4][2], const pg8::Unit& u, int wr, int wc, int fr, int fq, const LAS float* rsl) const {
#pragma unroll
        for (int ai = 0; ai < 2; ++ai)
#pragma unroll
            for (int m = 0; m < 4; ++m) { const int lr = ai * 128 + wr * 64 + m * 16 + fr, row = u.pm * 256 + lr; const float rs = rsl[lr];
#pragma unroll
                for (int bj = 0; bj < 2; ++bj) tile2(row, u.pn * 256 + bj * 128 + wc * 32, fq, rs, acc[ai][bj][m][0], acc[ai][bj][m][1]); }
    }
    __device__ __forceinline__ void wtile(int row, int colbase, int fq, const f32x4 (&v)[2]) const { tile2(row, colbase, fq, row_rs(SS, row), v[0], v[1]); }
};

template <int NB, int UNR, class Epi>
__device__ __forceinline__ void sgemm(const bf16_t* A, int lda, const bf16_t* Bt, int ldb, int K, int N, const Epi& E, int gw, int nw, int fr, int fq) {
    const int ncb = N / (16 * NB);
    for (int it = gw; it < 8 * ncb; it += nw) {
        const int rb = it & 7, cb = it >> 3, col0 = cb * 16 * NB, row = NP + rb * 16 + fr;
        const bf16_t* ap = A + (size_t)row * lda + fq * 8;
        const bf16_t* bp = Bt + (size_t)(col0 + fr) * ldb + fq * 8;
        f32x4 acc[NB];
#pragma unroll
        for (int n = 0; n < NB; ++n) acc[n] = (f32x4){0.f, 0.f, 0.f, 0.f};
        for (int k = 0; k < K; k += 32 * UNR) {
            bf16x8 a[UNR], b[UNR][NB];
#pragma unroll
            for (int u = 0; u < UNR; ++u) { a[u] = *(const bf16x8*)(ap + k + 32 * u);
#pragma unroll
                for (int n = 0; n < NB; ++n) b[u][n] = *(const bf16x8*)(bp + (size_t)n * 16 * ldb + k + 32 * u); }
#pragma unroll
            for (int u = 0; u < UNR; ++u)
#pragma unroll
                for (int n = 0; n < NB; ++n) acc[n] = __builtin_amdgcn_mfma_f32_16x16x32_bf16(b[u][n], a[u], acc[n], 0, 0, 0);
        }
        E.wtile(row, col0, fq, acc);
    }
}
template <class Epi>
__device__ __forceinline__ void sgemm4_splitk(const int tid, LAS unsigned char* lds, const bf16_t* A, int lda, const bf16_t* Bt, int ldb, int K, int agrp, const Epi& E) {
    const int wave = __builtin_amdgcn_readfirstlane(tid >> 6), lane = tid & 63, fr = lane & 15, fq = lane >> 4, G = gridDim.x;
    for (int it = bidx(); it < 128; it += G) {
        const int rb = it & 7, cb = it >> 3, col0 = cb * 64, row = NP + rb * 16 + fr, kper = K >> 3, kbeg = wave * kper, kend = kbeg + kper;
        const bf16_t* ap = A + (size_t)row * lda + (agrp ? (col0 & ~255) : 0) + fq * 8;
        const bf16_t* bp = Bt + (size_t)(col0 + fr) * ldb + fq * 8;
        f32x4 acc[4];
#pragma unroll
        for (int n = 0; n < 4; ++n) acc[n] = (f32x4){0.f, 0.f, 0.f, 0.f};
        for (int k = kbeg; k < kend; k += 192) {
            bf16x8 a[6], b[6][4];
#pragma unroll
            for (int u = 0; u < 6; ++u) if (k + 32 * u < kend) { a[u] = *(const bf16x8*)(ap + k + 32 * u);
#pragma unroll
                for (int n = 0; n < 4; ++n) b[u][n] = *(const bf16x8*)(bp + (size_t)n * 16 * ldb + k + 32 * u); }
#pragma unroll
            for (int u = 0; u < 6; ++u) if (k + 32 * u < kend) {
#pragma unroll
                for (int n = 0; n < 4; ++n) acc[n] = __builtin_amdgcn_mfma_f32_16x16x32_bf16(b[u][n], a[u], acc[n], 0, 0, 0); }
        }
#pragma unroll
        for (int n = 0; n < 4; ++n) *(LAS f32x4*)(lds + wave * 4096 + n * 1024 + lane * 16) = acc[n];
        __syncthreads();
        if (wave == 0) {
#pragma unroll
            for (int n = 0; n < 4; ++n) { f32x4 t = acc[n];
#pragma unroll
                for (int w = 1; w < 8; ++w) t = t + *(const LAS f32x4*)(lds + w * 4096 + n * 1024 + lane * 16);
                acc[n] = t; }
            E.wtile(row, col0, fq, acc);
        }
        __syncthreads();
    }
}

struct WTile { const float* src0; const float* src1; const float* gp; const float* vs; bf16_t* dst; float cmul; int lds_src, ldd, k0, v0, kind; };
__device__ __forceinline__ WTile wtile_decode(const Params& p, int t) {
    constexpr int T_GU = 4 * 16 * 22, T_WD = 4 * 44 * 4, T_WIN = 16 * 9, T_WOUT = 16 * 4;
    WTile w; w.src1 = nullptr; w.gp = nullptr; w.vs = nullptr; w.cmul = 1.0f;
    if (t < T_GU) { const int f = t / (16 * 22), tt = t % (16 * 22); w.k0 = (tt / 22) * 64; w.v0 = (tt % 22) * 256; w.kind = 1;
        w.src0 = p.w_gate + (size_t)f * DM * DFF; w.src1 = p.w_up + (size_t)f * DM * DFF; w.gp = p.norm_g + ((f >> 1) * 3 + ((f & 1) ? 2 : 0)) * DM; w.lds_src = DFF; w.ldd = DM; w.dst = (bf16_t*)(p.ws + WS_WGU) + (size_t)f * 5632 * DM; }
    else if (t < T_GU + T_WD) { const int t2 = t - T_GU, f = t2 / (44 * 4), tt = t2 % (44 * 4); w.k0 = (tt / 4) * 64; w.v0 = (tt % 4) * 256; w.kind = 0;
        w.src0 = p.w_down + (size_t)f * DFF * DM; w.cmul = 0.5f; w.lds_src = DM; w.ldd = DFF; w.dst = (bf16_t*)(p.ws + WS_WD) + (size_t)f * DM * DFF; }
    else if (t < T_GU + T_WD + T_WIN) { const int tt = t - T_GU - T_WD; w.k0 = (tt / 9) * 64; w.v0 = (tt % 9) * 256; w.kind = 2;
        w.src0 = p.mix_w_in; w.gp = p.norm_g + 1 * DM; w.lds_src = 2304; w.ldd = DM; w.dst = (bf16_t*)(p.ws + WS_WIN); }
    else if (t < T_GU + T_WD + T_WIN + T_WOUT) { const int tt = t - T_GU - T_WD - T_WIN; w.k0 = (tt / 4) * 64; w.v0 = (tt % 4) * 256; w.kind = 0;
        w.src0 = p.mix_w_out; w.lds_src = DM; w.ldd = DM; w.dst = (bf16_t*)(p.ws + WS_WOUT); }
    else { const int t2 = t - T_GU - T_WD - T_WIN - T_WOUT, gi = t2 >> 2, tt = t2 & 3; w.k0 = tt * 64; w.v0 = 0; w.kind = 0;
        w.src0 = p.pool_w + (size_t)gi * 65536; w.vs = p.pool_scale + gi * 256; w.lds_src = 256; w.ldd = 256; w.dst = (bf16_t*)(p.ws + WS_WP) + (size_t)gi * 65536; }
    return w;
}
__device__ __forceinline__ void wtile_load(const WTile& w, int tid, f32x4 (&q)[8]) {
#pragma unroll
    for (int i = 0; i < 8; ++i) { const int e = tid + 512 * i, kr = e >> 6, v = w.v0 + (e & 63) * 4; const float* sp = w.src0; int col = v;
        if (w.kind == 1) { col = 128 * (v >> 8) + 32 * ((v >> 5) & 3) + 8 * ((v >> 2) & 3) + 4 * ((v >> 7) & 1); if ((v >> 4) & 1) sp = w.src1; }
        else if (w.kind == 2) { if (v >= 1280) { const int x = v - 1280, j = x >> 5, ii = x & 31; col = ii < 16 ? 1280 + 16 * j + ii : 1792 + 16 * j + ii - 16; } }
        if (w.kind == 0) { const int rho = v & 31; col = (v & ~31) + 8 * ((rho & 15) >> 2) + 4 * (rho >> 4); }
        q[i] = __builtin_nontemporal_load((const f32x4*)(sp + (size_t)(w.k0 + kr) * w.lds_src + col)); if (w.gp) q[i] = q[i] * w.gp[w.k0 + kr]; if (w.vs) q[i] = q[i] * *(const f32x4*)(w.vs + col); q[i] = q[i] * w.cmul; }
}
__device__ __forceinline__ int late_tile(int j) {
    if (j < 352) return 352 + j;
    if (j < 528) return 1408 + 176 + (j - 352);
    if (j < 880) return 704 + (j - 528);
    if (j < 1056) return 1408 + 352 + (j - 880);
    if (j < 1408) return 1056 + (j - 1056);
    if (j < 1584) return 1408 + 528 + (j - 1408);
    return 2320 + (j - 1584);
}
constexpr int LATE_MIXIN = 640, LATE_ATTN = 1120, LATE_ALL = 1600, PRO_EARLY = 736;
__device__ __forceinline__ int pro_tile(int q) {
    if (q < 352) return q;
    if (q < 528) return 1408 + (q - 352);
    if (q < 672) return 2112 + (q - 528);
    if (q < 736) return 2256 + (q - 672);
    return late_tile(LATE_ATTN + (q - PRO_EARLY));
}
__device__ __forceinline__ void convert_range(const int tid, const Params& p, LAS unsigned char* lds, int first, int end, int stride, bool late) {
    LAS float* T = (LAS float*)lds;
    if (first >= end) return;
    f32x4 q[8]; int i = first; WTile cur = wtile_decode(p, late ? late_tile(i) : pro_tile(i));
    wtile_load(cur, tid, q);
    for (; i < end; i += stride) {
        __syncthreads();
#pragma unroll
        for (int k = 0; k < 8; ++k) { const int e = tid + 512 * k, kr = e >> 6, vv = (e & 63) * 4;
            T[kr * 257 + vv] = q[k][0]; T[kr * 257 + vv + 1] = q[k][1]; T[kr * 257 + vv + 2] = q[k][2]; T[kr * 257 + vv + 3] = q[k][3]; }
        bf16_t* dst = cur.dst; const int ldd = cur.ldd, k0 = cur.k0, v0 = cur.v0;
        if (i + stride < end) { cur = wtile_decode(p, late ? late_tile(i + stride) : pro_tile(i + stride)); wtile_load(cur, tid, q); }
        __syncthreads();
#pragma unroll
        for (int k = 0; k < 4; ++k) { const int e = tid + 512 * k, kq = (e & 7) * 8, vv = e >> 3;
            u32x4 wv; wv.x = cvt_pk_bf16(T[kq * 257 + vv], T[(kq + 1) * 257 + vv]); wv.y = cvt_pk_bf16(T[(kq + 2) * 257 + vv], T[(kq + 3) * 257 + vv]);
            wv.z = cvt_pk_bf16(T[(kq + 4) * 257 + vv], T[(kq + 5) * 257 + vv]); wv.w = cvt_pk_bf16(T[(kq + 6) * 257 + vv], T[(kq + 7) * 257 + vv]);
            *(u32x4*)(dst + (size_t)(v0 + vv) * ldd + k0 + kq) = wv; }
    }
}
__device__ __forceinline__ void prologue_phase(const int tid, const Params& p, LAS unsigned char* lds) {
    const int G = gridDim.x;
    convert_range(tid, p, lds, (int)bidx(), PRO_EARLY + (LATE_ALL - LATE_ATTN), G, false);
    const int lane = tid & 63, gw = (tid >> 6) * G + bidx(), nw = 8 * G;
    bf16_t* XB = (bf16_t*)(p.ws + WS_XB); float* SS = (float*)(p.ws + WS_SS);
    for (int r0 = gw; r0 < NR; r0 += 4 * nw) {
        f32x4 x[4][4];
#pragma unroll
        for (int r = 0; r < 4; ++r) { const int row = r0 + r * nw; if (row < NR) { const float* xp = row < NP ? p.x_prompt + (size_t)row * DM : p.x_sample + (size_t)(row - NP) * DM;
#pragma unroll
            for (int j = 0; j < 4; ++j) x[r][j] = __builtin_nontemporal_load((const f32x4*)(xp + lane * 8 + 512 * (j >> 1) + 4 * (j & 1))); } }
#pragma unroll
        for (int r = 0; r < 4; ++r) { const int row = r0 + r * nw; if (row < NR) { float ss = 0.f;
#pragma unroll
            for (int j = 0; j < 4; ++j) { const f32x4 v = x[r][j]; ss += (v[0] * v[0] + v[1] * v[1]) + (v[2] * v[2] + v[3] * v[3]); }
#pragma unroll
            for (int h = 0; h < 2; ++h) { const u32x2 a = pack4(x[r][2 * h]), b2 = pack4(x[r][2 * h + 1]); *(u32x4*)(XB + (size_t)row * DM + lane * 8 + 512 * h) = (u32x4){a.x, a.y, b2.x, b2.y}; }
#pragma unroll
            for (int o = 32; o >= 1; o >>= 1) ss += __shfl_xor(ss, o);
            if (lane < 16) SS[(size_t)row * 16 + lane] = lane == 0 ? ss : 0.f; } }
    }
}

__device__ __forceinline__ void attn_phase(const int tid, const Params& p, LAS unsigned char* lds) {
    LAS bf16_t* Ks = (LAS bf16_t*)lds;
    LAS bf16_t* Vt = (LAS bf16_t*)(lds + 27648);
    LAS float* TB = (LAS float*)(lds + 53248);
    const int wave = __builtin_amdgcn_readfirstlane(tid >> 6), lane = tid & 63, fr = lane & 15, fq = lane >> 4, G = gridDim.x;
    const bf16_t* Q = (const bf16_t*)(p.ws + WS_Q); const bf16_t* KB = (const bf16_t*)(p.ws + WS_KB); const bf16_t* VB = (const bf16_t*)(p.ws + WS_VB);
    const bf16_t* BG = (const bf16_t*)(p.ws + WS_BG); const bf16_t* U = (const bf16_t*)(p.ws + WS_U); bf16_t* MIX = (bf16_t*)(p.ws + WS_MIX);
    for (int i = tid; i < 8 * 256; i += 512) { const int h = i >> 8, rel = (i & 255) - 191, n = rel < 0 ? -rel : rel;
        int bk = n; if (n >= 8) { bk = 2 + (31 - __clz(n * n)); bk = bk > 15 ? 15 : bk; }
        bk += rel > 0 ? 16 : 0; TB[i] = p.rel_table[bk * 8 + h]; }
    for (int item = bidx(); item < 1040; item += G) {
        const bool smp = item >= 1024; int b, kvh, rowbase, kk_lo, kk_hi;
        if (!smp) { kvh = item & 1; const int c = (item >> 1) & 63; b = item >> 7; rowbase = b * SEQL + c * 64; kk_lo = 128 - c * 64; kk_lo = kk_lo < 0 ? 0 : kk_lo; kk_hi = 192; }
        else { const int i2 = item - 1024; kvh = i2 & 1; b = i2 >> 1; rowbase = NP + b * 16; kk_lo = 0; kk_hi = 144; }
        const int nunits = smp ? 4 : 16;
        bf16x8 qn[2];
        if (wave < nunits) { const int g0 = smp ? wave : (wave >> 2), qb0 = smp ? 0 : (wave & 3); const size_t qr0 = (size_t)rowbase + qb0 * 16 + fr;
#pragma unroll
            for (int ks = 0; ks < 2; ++ks) qn[ks] = *(const bf16x8*)(Q + qr0 * 512 + (kvh * 4 + g0) * 64 + ks * 32 + fq * 8); }
        const bool full = (kk_lo == 0 && kk_hi == 192);
        __syncthreads();
        u32x4 kvr[3], vvr[3];
#pragma unroll
        for (int it = 0; it < 3; ++it) { const int ch = tid + 512 * it, kk = ch >> 3, d8 = (ch & 7) * 8; u32x4 kv = (u32x4){0u, 0u, 0u, 0u}, vv = kv;
            if (kk >= kk_lo && kk < kk_hi) {
                if (smp && kk < 128) { const size_t o = ((size_t)(b * 128 + kk) * 2 + kvh) * 64 + d8;
                    const f32x4 k0 = *(const f32x4*)(p.cache_k + o), k1 = *(const f32x4*)(p.cache_k + o + 4), w0 = *(const f32x4*)(p.cache_v + o), w1 = *(const f32x4*)(p.cache_v + o + 4);
                    const u32x2 a = pack4(k0), bb = pack4(k1), c = pack4(w0), d = pack4(w1); kv = (u32x4){a.x, a.y, bb.x, bb.y}; vv = (u32x4){c.x, c.y, d.x, d.y}; }
                else { const size_t row = smp ? (size_t)(rowbase + kk - 128) : (size_t)(rowbase - 128 + kk);
                    kv = *(const u32x4*)(KB + row * 128 + kvh * 64 + d8); vv = *(const u32x4*)(VB + row * 128 + kvh * 64 + d8); } }
            kvr[it] = kv; vvr[it] = vv; }
#pragma unroll
        for (int it = 0; it < 3; ++it) { const int ch = tid + 512 * it, kk = ch >> 3, d8 = (ch & 7) * 8; const u32x4 kv = kvr[it], vv = vvr[it];
            *(LAS u32x4*)(Ks + kk * 72 + d8) = kv;
            Vt[(d8 + 0) * 200 + kk] = (bf16_t)(vv.x & 0xffffu); Vt[(d8 + 1) * 200 + kk] = (bf16_t)(vv.x >> 16);
            Vt[(d8 + 2) * 200 + kk] = (bf16_t)(vv.y & 0xffffu); Vt[(d8 + 3) * 200 + kk] = (bf16_t)(vv.y >> 16);
            Vt[(d8 + 4) * 200 + kk] = (bf16_t)(vv.z & 0xffffu); Vt[(d8 + 5) * 200 + kk] = (bf16_t)(vv.z >> 16);
            Vt[(d8 + 6) * 200 + kk] = (bf16_t)(vv.w & 0xffffu); Vt[(d8 + 7) * 200 + kk] = (bf16_t)(vv.w >> 16); }
        __syncthreads();
        for (int un = wave; un < nunits; un += 8) {
            const int g = smp ? un : (un >> 2), qb = smp ? 0 : (un & 3), head = kvh * 4 + g, qi = qb * 16 + fr; const size_t qrow = (size_t)rowbase + qi;
            bf16x8 qf[2]; qf[0] = qn[0]; qf[1] = qn[1];
            if (un + 8 < nunits) { const int un2 = un + 8, g2 = un2 >> 2, qb2 = un2 & 3; const size_t qr2 = (size_t)rowbase + qb2 * 16 + fr;
#pragma unroll
                for (int ks = 0; ks < 2; ++ks) qn[ks] = *(const bf16x8*)(Q + qr2 * 512 + (kvh * 4 + g2) * 64 + ks * 32 + fq * 8); }
            f32x4 s[12];
#pragma unroll
            for (int kb = 0; kb < 12; ++kb) { s[kb] = (f32x4){0.f, 0.f, 0.f, 0.f};
#pragma unroll
                for (int ks = 0; ks < 2; ++ks) { const bf16x8 a = *(const LAS bf16x8*)(Ks + (kb * 16 + fr) * 72 + ks * 32 + fq * 8); s[kb] = __builtin_amdgcn_mfma_f32_16x16x32_bf16(a, qf[ks], s[kb], 0, 0, 0); } }
            const float sink = p.sinks[head]; float mx = sink;
#pragma unroll
            for (int kb = 0; kb < 12; ++kb)
#pragma unroll
                for (int j = 0; j < 4; ++j) { const int kk = kb * 16 + 4 * fq + j; float v = s[kb][j] * 0.125f + TB[head * 256 + kk - 128 - qi + 191];
                    if (!full && (kk < kk_lo || kk >= kk_hi)) v = -1e30f; s[kb][j] = v; mx = fmaxf(mx, v); }
            mx = fmaxf(mx, __shfl_xor(mx, 16)); mx = fmaxf(mx, __shfl_xor(mx, 32));
            float sum = 0.f;
#pragma unroll
            for (int kb = 0; kb < 12; ++kb)
#pragma unroll
                for (int j = 0; j < 4; ++j) { const float e = __expf(s[kb][j] - mx); s[kb][j] = e; sum += e; }
            sum += __shfl_xor(sum, 16); sum += __shfl_xor(sum, 32);
            const float inv = 1.0f / (sum + __expf(sink - mx));
            bf16x8 pf[6];
#pragma unroll
            for (int k2 = 0; k2 < 6; ++k2) { const u32x2 a = pack4(s[2 * k2] * inv), c = pack4(s[2 * k2 + 1] * inv); const u32x4 w = (u32x4){a.x, a.y, c.x, c.y}; pf[k2] = __builtin_bit_cast(bf16x8, w); }
            int zv = 0; asm volatile("" : "+v"(zv));
#pragma unroll
            for (int db = 0; db < 4; ++db) { f32x4 o = (f32x4){0.f, 0.f, 0.f, 0.f};
#pragma unroll
                for (int k2 = 0; k2 < 6; ++k2) { const LAS bf16_t* vp = Vt + (db * 16 + fr) * 200 + 32 * k2 + 4 * fq + zv; const u32x2 a0 = *(const LAS u32x2*)vp, a1 = *(const LAS u32x2*)(vp + 16);
                    const u32x4 w = (u32x4){a0.x, a0.y, a1.x, a1.y}; o = __builtin_amdgcn_mfma_f32_16x16x32_bf16(__builtin_bit_cast(bf16x8, w), pf[k2], o, 0, 0, 0); }
                *(u32x2*)(MIX + qrow * 1024 + head * 64 + db * 16 + 4 * fq) = pack4(o); }
        }
    }
    {
        const int c = (tid & 63) * 8, rsub = tid >> 6, nrb = NR / 8;
        float w0[8], w1[8], w2[8];
#pragma unroll
        for (int j = 0; j < 8; ++j) { w0[j] = p.conv_w[c + j]; w1[j] = p.conv_w[512 + c + j]; w2[j] = p.conv_w[1024 + c + j]; }
        for (int rb0 = bidx(); rb0 < nrb; rb0 += 4 * G) {
            u32x4 a0[4], a1[4], a2[4], ab[4]; bool ok[4];
#pragma unroll
            for (int r = 0; r < 4; ++r) { const int rb = rb0 + r * G; ok[r] = rb < nrb; if (ok[r]) { const int row = rb * 8 + rsub; const bool smp = row >= NP; const int s1 = smp ? ((row - NP) & 15) : (row & 4095);
                a0[r] = *(const u32x4*)(U + (size_t)row * 512 + c); ab[r] = *(const u32x4*)(BG + (size_t)row * 512 + c);
                if (s1 >= 1) a1[r] = *(const u32x4*)(U + (size_t)(row - 1) * 512 + c);
                if (s1 >= 2) a2[r] = *(const u32x4*)(U + (size_t)(row - 2) * 512 + c); } }
#pragma unroll
            for (int r = 0; r < 4; ++r) if (ok[r]) { const int row = (rb0 + r * G) * 8 + rsub; const bool smp = row >= NP; int b, s1; if (!smp) { b = row >> 12; s1 = row & 4095; } else { b = (row - NP) >> 4; s1 = (row - NP) & 15; }
                float u0[8], u1[8], u2[8], bg[8];
                { const u32x4 w = a0[r]; u0[0] = bf_lo(w.x); u0[1] = bf_hi(w.x); u0[2] = bf_lo(w.y); u0[3] = bf_hi(w.y); u0[4] = bf_lo(w.z); u0[5] = bf_hi(w.z); u0[6] = bf_lo(w.w); u0[7] = bf_hi(w.w); }
                { const u32x4 w = ab[r]; bg[0] = bf_lo(w.x); bg[1] = bf_hi(w.x); bg[2] = bf_lo(w.y); bg[3] = bf_hi(w.y); bg[4] = bf_lo(w.z); bg[5] = bf_hi(w.z); bg[6] = bf_lo(w.w); bg[7] = bf_hi(w.w); }
                if (s1 >= 1) { const u32x4 w = a1[r]; u1[0] = bf_lo(w.x); u1[1] = bf_hi(w.x); u1[2] = bf_lo(w.y); u1[3] = bf_hi(w.y); u1[4] = bf_lo(w.z); u1[5] = bf_hi(w.z); u1[6] = bf_lo(w.w); u1[7] = bf_hi(w.w); }
                else {
#pragma unroll
                    for (int j = 0; j < 8; ++j) u1[j] = smp ? p.cache_conv[(size_t)(b * 2 + 1) * 512 + c + j] : 0.f; }
                if (s1 >= 2) { const u32x4 w = a2[r]; u2[0] = bf_lo(w.x); u2[1] = bf_hi(w.x); u2[2] = bf_lo(w.y); u2[3] = bf_hi(w.y); u2[4] = bf_lo(w.z); u2[5] = bf_hi(w.z); u2[6] = bf_lo(w.w); u2[7] = bf_hi(w.w); }
                else {
#pragma unroll
                    for (int j = 0; j < 8; ++j) u2[j] = smp ? p.cache_conv[(size_t)(b * 2 + s1) * 512 + c + j] : 0.f; }
                float y[8];
#pragma unroll
                for (int j = 0; j < 8; ++j) y[j] = bg[j] * (w0[j] * u2[j] + w1[j] * u1[j] + w2[j] * u0[j]);
                u32x4 w; w.x = cvt_pk_bf16(y[0], y[1]); w.y = cvt_pk_bf16(y[2], y[3]); w.z = cvt_pk_bf16(y[4], y[5]); w.w = cvt_pk_bf16(y[6], y[7]);
                *(u32x4*)(MIX + (size_t)row * 1024 + 512 + c) = w; }
        }
    }
    { const int nx = 1040 % G, cw = (int)bidx(); if (cw >= nx) convert_range(tid, p, lds, LATE_MIXIN + cw - nx, LATE_ATTN, G - nx, true); }
}

__device__ __forceinline__ f32x4 pool_h(const Params& p, const bf16_t* X, const LAS float* rsl, bool smp, int b, int seqrow0, int t0, int t, int col, f32x4 g4) {
    if (t < 0) { if (!smp) return (f32x4){0.f, 0.f, 0.f, 0.f}; return *(const f32x4*)(p.cache_pool + (size_t)(b * 15 + 15 + t) * DM + col); }
    const float r = rsl[t - t0 + 16]; const f32x4 x = unpack4(*(const u32x2*)(X + (size_t)(seqrow0 + t) * DM + col)); return x * r * g4;
}
__device__ __forceinline__ void pooldiff_phase(const int tid, const Params& p, LAS unsigned char* lds) {
    LAS float* RS = (LAS float*)lds;
    const int half = tid >> 8, tl = tid & 255, G = gridDim.x;
    const bf16_t* X = (const bf16_t*)(p.ws + WS_XB); const float* SS = (const float*)(p.ws + WS_SS); bf16_t* D = (bf16_t*)(p.ws + WS_MIX);
    const int col = tl * 4, w = 2 << (col >> 8); const f32x4 g4 = *(const f32x4*)(p.norm_g + 4 * DM + col); const float invw = 1.0f / (float)w;
    for (int item = bidx(); item < 256 + 4; item += G) {
        const bool smp = item >= 256; int b, t0, nrows, seqrow0, T0;
        if (!smp) { const int blk = item * 2 + half; b = blk >> 6; t0 = (blk & 63) * 64; nrows = 64; seqrow0 = b * SEQL; T0 = 0; }
        else { b = (item - 256) * 2 + half; t0 = 0; nrows = 16; seqrow0 = NP + b * 16; T0 = 1024; }
        __syncthreads();
        if (tl < 80) { const int t = t0 - 16 + tl; if (t >= 0 && t < t0 + nrows) RS[half * 80 + tl] = row_rs(SS, seqrow0 + t); }
        __syncthreads();
        const LAS float* rsl = RS + half * 80;
        f32x4 hh[15];
#pragma unroll
        for (int j = 1; j < 16; ++j) if (j < w) hh[j - 1] = pool_h(p, X, rsl, smp, b, seqrow0, t0, t0 - j, col, g4);
        f32x4 sp = (f32x4){0.f, 0.f, 0.f, 0.f};
#pragma unroll
        for (int j = 1; j < 16; ++j) if (j < w) sp = sp + hh[j - 1];
        for (int tb = t0; tb < t0 + nrows; tb += 16) {
            f32x4 h8[16], o8[16];
#pragma unroll
            for (int j = 0; j < 16; ++j) { h8[j] = pool_h(p, X, rsl, smp, b, seqrow0, t0, tb + j, col, g4); o8[j] = pool_h(p, X, rsl, smp, b, seqrow0, t0, tb + j - w + 1, col, g4); }
#pragma unroll
            for (int j = 0; j < 16; ++j) { const int t = tb + j; const f32x4 h = h8[j]; const f32x4 s = sp + h;
                const int cnt = (T0 + t + 1) < w ? (T0 + t + 1) : w; const float ic = cnt == w ? invw : 1.0f / (float)cnt;
                const f32x4 d = s * ic - h;
                *(u32x2*)(D + (size_t)(seqrow0 + t) * DM + col) = pack4(d);
                sp = s - o8[j];
                if (!smp) { if (t >= SEQL - 15) *(f32x4*)(p.out + O_POOLP + (size_t)(b * 15 + t - (SEQL - 15)) * DM + col) = h; }
                else { if (t >= 1) *(f32x4*)(p.out + O_POOLS + (size_t)(b * 15 + t - 1) * DM + col) = h; } }
        }
    }
}

__device__ __forceinline__ void final_phase(const int tid, const Params& p) {
    const int lane = tid & 63, G = gridDim.x, gw = (tid >> 6) * G + bidx(), nw = 8 * G;
    const bf16_t* X = (const bf16_t*)(p.ws + WS_XB); const float* SS = (const float*)(p.ws + WS_SS);
    f32x4 g[4];
#pragma unroll
    for (int j = 0; j < 4; ++j) g[j] = *(const f32x4*)(p.final_g + lane * 4 + 256 * j);
    for (int r0 = gw; r0 < NR; r0 += 4 * nw) {
        f32x4 x[4][4]; float rs[4];
#pragma unroll
        for (int r = 0; r < 4; ++r) { const int row = r0 + r * nw; if (row < NR) { rs[r] = row_rs(SS, row);
#pragma unroll
            for (int j = 0; j < 4; ++j) x[r][j] = unpack4(*(const u32x2*)(X + (size_t)row * DM + lane * 4 + 256 * j)); } }
#pragma unroll
        for (int r = 0; r < 4; ++r) { const int row = r0 + r * nw; if (row < NR) { float* dst = row < NP ? p.out + O_YP + (size_t)row * DM : p.out + O_YS + (size_t)(row - NP) * DM;
#pragma unroll
            for (int j = 0; j < 4; ++j) __builtin_nontemporal_store(x[r][j] * rs[r] * g[j], (f32x4*)(dst + lane * 4 + 256 * j)); } }
    }
}

__device__ __forceinline__ void grid_bar(unsigned* bar, unsigned k) {
    asm volatile("s_waitcnt vmcnt(0)" ::: "memory");
    __syncthreads();
    if (threadIdx.x == 0) {
        const unsigned g = bidx() & 7u, per = (gridDim.x + 7u - g) >> 3, ngrp = gridDim.x < 8u ? gridDim.x : 8u;
        __builtin_amdgcn_fence(__ATOMIC_RELEASE, "agent");
        asm volatile("s_waitcnt vmcnt(0)" ::: "memory");
        const unsigned old = __hip_atomic_fetch_add(bar + 64 * g, 1u, __ATOMIC_RELAXED, __HIP_MEMORY_SCOPE_AGENT);
        if (old + 1u == per * k) {
            const unsigned ot = __hip_atomic_fetch_add(bar + 64 * 8, 1u, __ATOMIC_RELAXED, __HIP_MEMORY_SCOPE_AGENT);
            if (ot + 1u == ngrp * k) {
#pragma unroll
                for (int j = 0; j < 8; ++j) __hip_atomic_store(bar + 64 * (9 + j), k, __ATOMIC_RELAXED, __HIP_MEMORY_SCOPE_AGENT);
            }
        }
        while (__hip_atomic_load(bar + 64 * (9 + g), __ATOMIC_RELAXED, __HIP_MEMORY_SCOPE_AGENT) < k) __builtin_amdgcn_s_sleep(1);
        __builtin_amdgcn_fence(__ATOMIC_ACQUIRE, "agent");
        asm volatile("s_waitcnt vmcnt(0)" ::: "memory");
    }
    __syncthreads();
}

enum { K_PRO = 0, K_G1, K_RES, K_MIXIN, K_ATTN, K_PDIFF, K_FINAL, K_DUMP };
#ifndef DBG_LAST
#define DBG_LAST -1
#endif
__device__ __forceinline__ void dump_phase(const int tid, const Params& p) {
    const int G = gridDim.x; const size_t gt = (size_t)bidx() * 512 + tid, nt = (size_t)G * 512;
    const bf16_t* XB = (const bf16_t*)(p.ws + WS_XB); const float* SS = (const float*)(p.ws + WS_SS);
#if DBG_LAST == 3 || DBG_LAST == 4
    const bf16_t* AR = (const bf16_t*)(p.ws + WS_ACT);
    for (size_t i = gt; i < (size_t)NR * DM; i += nt) { float v = __uint_as_float((unsigned)AR[i] << 16) + __uint_as_float((unsigned)AR[i + (size_t)NR * DM] << 16); if (i < (size_t)NR * 768) v += __uint_as_float((unsigned)AR[i + (size_t)2 * NR * DM] << 16); p.out[i] = v; }
#else
    for (size_t i = gt; i < (size_t)NR * DM; i += nt) { const int row = (int)(i >> 10); p.out[i] = __uint_as_float((unsigned)XB[i] << 16) * row_rs(SS, row); }
#endif
    for (size_t i = (size_t)NR * DM + gt; i < O_POOLS + 122880; i += nt) p.out[i] = 0.f;
}
__global__ void __launch_bounds__(512, 2) mk_fwd(Params pk) {
    extern __shared__ __attribute__((aligned(16))) unsigned char smem[];
    LAS unsigned char* lds = (LAS unsigned char*)smem;
    const int G = gridDim.x;
    unsigned nbar = 0;
    if (pk.ph_lo < 0) cg::this_grid().sync();
    for (int ph = pk.ph_lo; ph < pk.ph_hi; ++ph)
    for (int rep = 0; rep < 1 + ((PROBE_DUP >> ph) & 1); ++rep) {
        int tid = threadIdx.x; asm volatile("" : "+v"(tid));
        Params p = pk; { size_t z = 0; asm volatile("" : "+s"(z)); p.ws = pk.ws + z; p.out = pk.out + z; }
        bf16_t* XB = (bf16_t*)(p.ws + WS_XB); float* SS = (float*)(p.ws + WS_SS); bf16_t* ACT = (bf16_t*)(p.ws + WS_ACT); bf16_t* MIX = (bf16_t*)(p.ws + WS_MIX);
        int kind, f = 0;
        switch (ph) {
            case 0: kind = K_PRO; break;
            case 1: kind = K_G1; f = 0; break;   case 2: kind = K_RES; f = 0; break;
            case 3: kind = K_MIXIN; break;       case 4: kind = K_ATTN; break;       case 5: kind = K_RES; f = 4; break;
            case 6: kind = K_G1; f = 1; break;   case 7: kind = K_RES; f = 1; break;
            case 8: kind = K_G1; f = 2; break;   case 9: kind = K_RES; f = 2; break;
            case 10: kind = K_PDIFF; break;      case 11: kind = K_RES; f = 5; break;
            case 12: kind = K_G1; f = 3; break;  case 13: kind = K_RES; f = 3; break;
            case 14: kind = K_FINAL; break;
            default: kind = K_DUMP; break;
        }
        if (kind == K_PRO) prologue_phase(tid, p, lds);
        else if (kind == K_G1) {
            const bf16_t* W = (const bf16_t*)(p.ws + WS_WGU) + (size_t)f * 5632 * DM;
            EpiSwiglu E{SS, ACT};
            { const int lane = tid & 63; sgemm<2, 4>(XB, DM, W, DM, DM, 5632, E, __builtin_amdgcn_readfirstlane(tid >> 6) * G + bidx(), 8 * G, lane & 15, lane >> 4); }
            pg8::Gemm g{XB, W, 128, 22, DM, DM, DM, 0}; pg8::StaticOrder S; S.init(128, 22, G, (int)bidx());
            pg8::gemm_phase(tid, lds, g, S, E);
        } else if (kind == K_RES) {
            pg8::Gemm g; EpiResid E; E.XB = XB; E.SS = SS; int K, agrp = 0;
            if (f < 4) { g = pg8::Gemm{ACT, (const bf16_t*)(p.ws + WS_WD) + (size_t)f * DM * DFF, 128, 4, DFF, DFF, DFF, 0}; K = DFF; }
            else if (f == 4) { g = pg8::Gemm{MIX, (const bf16_t*)(p.ws + WS_WOUT), 128, 4, DM, DM, DM, 0}; K = DM; }
            else { g = pg8::Gemm{MIX, (const bf16_t*)(p.ws + WS_WP), 128, 4, 256, DM, 256, 256}; K = 256; agrp = 1; }
            sgemm4_splitk(tid, lds, g.A, g.lda, g.Bt, g.ldb, K, agrp, E);
            pg8::StaticOrder S; S.init(128, 4, G, (int)bidx());
            pg8::gemm_phase(tid, lds, g, S, E);
        } else if (kind == K_MIXIN) {
            const bf16_t* W = (const bf16_t*)(p.ws + WS_WIN);
            EpiMixIn E{SS, (bf16_t*)(p.ws + WS_Q), (bf16_t*)(p.ws + WS_KB), (bf16_t*)(p.ws + WS_VB), (bf16_t*)(p.ws + WS_BG), (bf16_t*)(p.ws + WS_U), p.out};
            { const int lane = tid & 63; sgemm<2, 4>(XB, DM, W, DM, DM, 2304, E, __builtin_amdgcn_readfirstlane(tid >> 6) * G + bidx(), 8 * G, lane & 15, lane >> 4); }
            pg8::Gemm g{XB, W, 128, 9, DM, DM, DM, 0}; pg8::StaticOrder S; S.init(128, 9, G, (int)bidx());
            pg8::gemm_phase(tid, lds, g, S, E);
            { const int nx = 1152 % G, c = (int)bidx(); if (c >= nx) convert_range(tid, p, lds, c - nx, LATE_MIXIN, G - nx, true); }
        } else if (kind == K_ATTN) attn_phase(tid, p, lds);
        else if (kind == K_PDIFF) pooldiff_phase(tid, p, lds);
        else if (kind == K_DUMP) dump_phase(tid, p);
        else final_phase(tid, p);
        if (ph + 1 < pk.ph_hi || rep < ((PROBE_DUP >> ph) & 1)) { grid_bar((unsigned*)(pk.ws + WS_BAR), nbar + 1);
            if (PROBE_SYNC) { ++nbar; grid_bar((unsigned*)(pk.ws + WS_BAR), nbar + 1); ++nbar; grid_bar((unsigned*)(pk.ws + WS_BAR), nbar + 1); }
            ++nbar; }
    }
}

extern "C" void kernel_launch(void* const* d_in, const int* in_sizes, int n_in, void* d_out, int out_size, void* d_ws, size_t ws_size, hipStream_t stream) {
    static int grid = 0;
    if (grid == 0) {
        if (ws_size < WS_END) { fprintf(stderr, "kernel_launch: workspace too small: %zu < %zu\n", ws_size, (size_t)WS_END); grid = -1; return; }
        if (hipFuncSetAttribute((const void*)mk_fwd, hipFuncAttributeMaxDynamicSharedMemorySize, LDS_BYTES) != hipSuccess) { fprintf(stderr, "kernel_launch: hipFuncSetAttribute failed\n"); grid = -1; return; }
        int dev = 0, cus = 0, per_cu = 0;
        (void)hipGetDevice(&dev); (void)hipDeviceGetAttribute(&cus, hipDeviceAttributeMultiprocessorCount, dev);
        (void)hipOccupancyMaxActiveBlocksPerMultiprocessor(&per_cu, (const void*)mk_fwd, 512, LDS_BYTES);
        if (per_cu < 1) { fprintf(stderr, "kernel_launch: occupancy query says %d blocks per CU\n", per_cu); per_cu = 1; }
        (void)hipGetLastError();
        grid = cus;
    }
    if (grid < 0) return;
    Params p{};
    p.x_prompt = (const float*)d_in[0]; p.x_sample = (const float*)d_in[1]; p.cache_k = (const float*)d_in[2]; p.cache_v = (const float*)d_in[3]; p.cache_conv = (const float*)d_in[4]; p.cache_pool = (const float*)d_in[5];
    p.norm_g = (const float*)d_in[6]; p.w_gate = (const float*)d_in[7]; p.w_up = (const float*)d_in[8]; p.w_down = (const float*)d_in[9]; p.mix_w_in = (const float*)d_in[10]; p.mix_w_out = (const float*)d_in[11];
    p.conv_w = (const float*)d_in[12]; p.sinks = (const float*)d_in[13]; p.rel_table = (const float*)d_in[14]; p.pool_w = (const float*)d_in[15]; p.pool_scale = (const float*)d_in[16]; p.final_g = (const float*)d_in[17];
    p.out = (float*)d_out; p.ws = (unsigned char*)d_ws;
#if MK_MULTI
#if DBG_LAST >= 0
    for (int ph = 0; ph <= DBG_LAST; ++ph) { p.ph_lo = ph; p.ph_hi = ph + 1; hipLaunchKernelGGL(mk_fwd, dim3(grid), dim3(512), LDS_BYTES, stream, p); }
    p.ph_lo = 15; p.ph_hi = 16; hipLaunchKernelGGL(mk_fwd, dim3(grid), dim3(512), LDS_BYTES, stream, p);
#else
    for (int ph = 0; ph < NPH; ++ph) { p.ph_lo = ph; p.ph_hi = ph + 1; hipLaunchKernelGGL(mk_fwd, dim3(grid), dim3(512), LDS_BYTES, stream, p); }
#endif
#else
    p.ph_lo = 0; p.ph_hi = NPH;
    (void)hipMemsetAsync((unsigned char*)d_ws + WS_BAR, 0, 17 * 256, stream);
    void* args[] = {&p};
    hipError_t e = hipLaunchCooperativeKernel((const void*)mk_fwd, dim3(grid), dim3(512), args, LDS_BYTES, stream);
    if (e != hipSuccess) fprintf(stderr, "kernel_launch: cooperative launch failed: %s (grid %d)\n", hipGetErrorString(e), grid);
#endif
}
```

```cpp
#include <hip/hip_runtime.h>
#include <hip/hip_cooperative_groups.h>
#include <cstdio>
namespace cg = cooperative_groups;

#ifndef PROBE_DUP
#define PROBE_DUP 0
#endif
#ifndef PROBE_K2
#define PROBE_K2 0
#endif
#ifndef PROBE_EPI2
#define PROBE_EPI2 0
#endif
#ifndef PROBE_SYNC
#define PROBE_SYNC 0
#endif
#ifndef MK_MULTI
#define MK_MULTI 0
#endif

#define LAS __attribute__((address_space(3)))
typedef unsigned short bf16_t;
typedef short bf16x8 __attribute__((ext_vector_type(8)));
typedef float f32x4 __attribute__((ext_vector_type(4)));
typedef unsigned u32x4 __attribute__((ext_vector_type(4)));
typedef unsigned u32x2 __attribute__((ext_vector_type(2)));

constexpr int DM = 1024, SEQL = 4096, NP = 32768, NS = 128, NR = NP + NS, DFF = 2816;
constexpr int NPH = 15;
constexpr int LDS_BYTES = 131072 + 1024;
constexpr size_t O_YP = 0, O_YS = 33554432, O_KP = O_YS + 131072, O_VP = O_KP + 131072, O_CONVP = O_VP + 131072, O_POOLP = O_CONVP + 8192,
                 O_KS = O_POOLP + 122880, O_VS = O_KS + 16384, O_CONVS = O_VS + 16384, O_POOLS = O_CONVS + 8192;
constexpr size_t WS_X = 0;
constexpr size_t WS_XB = WS_X + (size_t)NR * DM * 4;
constexpr size_t WS_ACT = WS_XB + (size_t)NR * DM * 2;
constexpr size_t WS_Q = WS_ACT;
constexpr size_t WS_KB = WS_Q + (size_t)NR * 512 * 2;
constexpr size_t WS_VB = WS_KB + (size_t)NR * 128 * 2;
constexpr size_t WS_BG = WS_VB + (size_t)NR * 128 * 2;
constexpr size_t WS_U = WS_BG + (size_t)NR * 512 * 2;
constexpr size_t WS_MIX = WS_U + (size_t)NR * 512 * 2;
constexpr size_t WS_SS = WS_ACT + (size_t)NR * DFF * 2;
constexpr size_t WS_WGU = WS_SS + (size_t)NR * 16 * 4;
constexpr size_t WS_WD = WS_WGU + (size_t)4 * 5632 * 1024 * 2;
constexpr size_t WS_WIN = WS_WD + (size_t)4 * 1024 * 2816 * 2;
constexpr size_t WS_WOUT = WS_WIN + (size_t)2304 * 1024 * 2;
constexpr size_t WS_WP = WS_WOUT + (size_t)1024 * 1024 * 2;
constexpr size_t WS_BAR = WS_WP + (size_t)1024 * 256 * 2;
constexpr size_t WS_END = WS_BAR + 17 * 256;
static_assert(WS_MIX + (size_t)NR * 1024 * 2 == WS_SS, "mixer buffers alias ACT exactly");

struct Params {
    const float *x_prompt, *x_sample, *cache_k, *cache_v, *cache_conv, *cache_pool, *norm_g, *w_gate, *w_up, *w_down, *mix_w_in, *mix_w_out, *conv_w, *sinks, *rel_table, *pool_w, *pool_scale, *final_g;
    float* out; unsigned char* ws; int ph_lo, ph_hi;
};

__device__ __forceinline__ int bidx() { int b = (int)blockIdx.x; asm volatile("" : "+s"(b)); return b; }
typedef float f32x2_t __attribute__((ext_vector_type(2)));
typedef __bf16 bf16x2_t __attribute__((ext_vector_type(2)));
__device__ __forceinline__ unsigned cvt_pk_bf16(float lo, float hi) { const f32x2_t v = {lo, hi}; const bf16x2_t b = __builtin_convertvector(v, bf16x2_t); return __builtin_bit_cast(unsigned, b); }
__device__ __forceinline__ u32x2 pack4(f32x4 v) { u32x2 w; w.x = cvt_pk_bf16(v[0], v[1]); w.y = cvt_pk_bf16(v[2], v[3]); return w; }
__device__ __forceinline__ float bf_lo(unsigned w) { return __uint_as_float(w << 16); }
__device__ __forceinline__ float bf_hi(unsigned w) { return __uint_as_float(w & 0xffff0000u); }
__device__ __forceinline__ float row_rs(const float* SS, int row) {
    const f32x4* p = (const f32x4*)(SS + (size_t)row * 16); const f32x4 a = p[0], b = p[1], c = p[2], d = p[3];
    const f32x4 s = (a + b) + (c + d); const float t = (s[0] + s[1]) + (s[2] + s[3]);
    return __builtin_amdgcn_rsqf(t * (1.0f / 1024.0f) + 1e-6f);
}

namespace pg8 {
constexpr int BM = 256, BK = 64, HALF = 128, HTB = HALF * BK * 2, NXCD = 8, WGM = 8;
__device__ __forceinline__ int lds_byte(int r, int c) { const int st = (r >> 4) * 2 + (c >> 5), rr = r & 15, cc = c & 31, ob = rr * 64 + cc * 2; return st * 1024 + (ob ^ (((ob >> 9) & 1) << 5)); }
__device__ __forceinline__ void stage_rc(int b, int& R, int& C) { const int st = b / 1024, sb = b % 1024, swz = sb ^ (((sb >> 9) & 1) << 5); R = (st >> 1) * 16 + swz / 64; C = (st & 1) * 32 + (swz % 64) / 2; }
struct Unit { int pm, pn; };
struct Gemm { const bf16_t* A; const bf16_t* Bt; int nM, nN, K, lda, ldb, apn; };
struct StaticOrder {
    int nM, nN, nwg, G, c;
    __device__ void init(int nM_, int nN_, int G_, int c_) { nM = nM_; nN = nN_; nwg = nM * nN; G = G_; c = c_; }
    __device__ bool next(int i, Unit& u) const {
        const long L = (long)i * G + c; if (L >= nwg) return false;
        if (nM == 128) {
            const int xcd = (int)L & 7, off = (int)L >> 3, nig8 = 8 * nN, hi = off >= nig8, rem = off - (hi ? nig8 : 0);
            u.pm = (2 * xcd + hi) * 8 + (rem & 7); u.pn = rem >> 3; return true;
        }
        int wgid = (int)L; { const int q = nwg / NXCD, r = nwg % NXCD, xcd = wgid % NXCD, off = wgid / NXCD; wgid = (xcd < r ? xcd * (q + 1) : r * (q + 1) + (xcd - r) * q) + off; }
        const int nig = WGM * nN, gid = wgid / nig, fm = gid * WGM, gsz = (nM - fm) < WGM ? (nM - fm) : WGM;
        u.pm = fm + ((wgid % nig) % gsz); u.pn = (wgid % nig) / gsz; return true;
    }
};

template <class Epi>
__device__ __forceinline__ void gemm_phase(const int tid, LAS unsigned char* lds, const Gemm g, const StaticOrder& S, const Epi& E) {
    const int wid = __builtin_amdgcn_readfirstlane(tid >> 6), lane = tid & 63, wr = wid >> 2, wc = wid & 3, fr = lane & 15, fq = lane >> 4;
    const int K = g.K, nt = K / BK;
    unsigned voffA[2], voffB[2];
#pragma unroll
    for (int i = 0; i < 2; ++i) { int R, C; stage_rc(tid * 16 + i * 8192, R, C); voffA[i] = (unsigned)(R * g.lda + C) * 2u; voffB[i] = (unsigned)(R * g.ldb + C) * 2u; }
    const size_t kstep = (size_t)(BK * 2);
    const size_t hA = (size_t)HALF * g.lda * 2, hB = (size_t)HALF * g.ldb * 2;
    const unsigned ldsw = (unsigned)wid * 1024u;
    const int aoff = lds_byte(wr * 64 + fr, fq * 8), boff = lds_byte(wc * 32 + fr, fq * 8);
#define PG8_SA(b, h) (((b) * 2 + (h)) * HTB)
#define PG8_SB(b, h) ((4 + (b) * 2 + (h)) * HTB)
#define PG8_STAGE(bufoff, gbase, voff) do { _Pragma("unroll") for (int _i = 0; _i < 2; ++_i) \
        __builtin_amdgcn_global_load_lds((const unsigned*)((const char*)(gbase) + (voff)[_i]), (LAS unsigned*)(lds + (bufoff) + ldsw + _i * 8192), 16, 0, 0); } while (0)
#define PG8_LDA(dst, b, h) do { _Pragma("unroll") for (int m = 0; m < 4; ++m) _Pragma("unroll") for (int k = 0; k < 2; ++k) dst[m][k] = *(const LAS bf16x8*)(lds + PG8_SA(b, h) + aoff + m * 2048 + k * 1024); } while (0)
#define PG8_LDB(dst, b, h) do { _Pragma("unroll") for (int n = 0; n < 2; ++n) _Pragma("unroll") for (int k = 0; k < 2; ++k) dst[n][k] = *(const LAS bf16x8*)(lds + PG8_SB(b, h) + boff + n * 2048 + k * 1024); } while (0)
#define PG8_MMA(ai, bj, At, Bt) do { __builtin_amdgcn_s_setprio(1); _Pragma("unroll") for (int m = 0; m < 4; ++m) _Pragma("unroll") for (int n = 0; n < 2; ++n) _Pragma("unroll") for (int k = 0; k < 2; ++k) \
        acc[ai][bj][m][n] = __builtin_amdgcn_mfma_f32_16x16x32_bf16(Bt[n][k], At[m][k], acc[ai][bj][m][n], 0, 0, 0); __builtin_amdgcn_s_setprio(0); } while (0)
#define PG8_WAIT_V(n) asm volatile("s_waitcnt vmcnt(" #n ")" ::: "memory")
#define PG8_WAIT_L(n) asm volatile("s_waitcnt lgkmcnt(" #n ")" ::: "memory")
#define PG8_BAR __builtin_amdgcn_s_barrier()
#define PG8_SCHED __builtin_amdgcn_sched_barrier(0)
    Unit cur, nxt; int ui = 0, last_pm = -1; LAS float* rsl = (LAS float*)(lds + 131072);
    if (!S.next(0, cur)) return;
    f32x4 acc[2][2][4][2];
#pragma unroll
    for (int a = 0; a < 2; ++a)
#pragma unroll
        for (int b = 0; b < 2; ++b)
#pragma unroll
            for (int m = 0; m < 4; ++m)
#pragma unroll
                for (int n = 0; n < 2; ++n) acc[a][b][m][n] = (f32x4){0.f, 0.f, 0.f, 0.f};
    bf16x8 At[4][2], B0[2][2], B1[2][2];
    const char* cA = (const char*)g.A + ((size_t)cur.pm * 256 * g.lda + (size_t)cur.pn * g.apn) * 2; const char* cB = (const char*)g.Bt + (size_t)cur.pn * 256 * g.ldb * 2;
    PG8_STAGE(PG8_SB(0, 0), cB, voffB); PG8_STAGE(PG8_SA(0, 0), cA, voffA); PG8_STAGE(PG8_SB(0, 1), cB + hB, voffB); PG8_STAGE(PG8_SA(0, 1), cA + hA, voffA);
    if (wr == 1) PG8_BAR;
    PG8_WAIT_V(4); PG8_BAR;
    PG8_STAGE(PG8_SB(1, 0), cB + kstep, voffB); PG8_STAGE(PG8_SA(1, 0), cA + kstep, voffA); PG8_STAGE(PG8_SB(1, 1), cB + hB + kstep, voffB);
    PG8_WAIT_V(6); PG8_BAR;
    for (;;) {
        const bool has_next = S.next(PROBE_K2 ? ((ui + 1) >> 1) : (ui + 1), nxt);
        const char* nA = has_next ? (const char*)g.A + ((size_t)nxt.pm * 256 * g.lda + (size_t)nxt.pn * g.apn) * 2 : cA; const char* nB = has_next ? (const char*)g.Bt + (size_t)nxt.pn * 256 * g.ldb * 2 : cB;
        for (int t = 0; t < nt; t += 2) {
            const bool last = (t == nt - 2);
            const char* a1 = cA + (size_t)(t + 1) * kstep;
            const char* a2 = last ? nA : cA + (size_t)(t + 2) * kstep; const char* b2 = last ? nB : cB + (size_t)(t + 2) * kstep;
            const char* a3 = a2 + kstep; const char* b3 = b2 + kstep;
            PG8_LDB(B0, 0, 0); PG8_SCHED; PG8_LDA(At, 0, 0); PG8_STAGE(PG8_SA(1, 1), a1 + hA, voffA);
            PG8_WAIT_L(8); PG8_BAR; PG8_WAIT_L(0); PG8_MMA(0, 0, At, B0); PG8_BAR; PG8_SCHED;
            PG8_LDB(B1, 0, 1); PG8_STAGE(PG8_SB(0, 0), b2, voffB);
            PG8_BAR; PG8_WAIT_L(0); PG8_MMA(0, 1, At, B1); PG8_BAR;
            PG8_LDA(At, 0, 1); PG8_STAGE(PG8_SA(0, 0), a2, voffA);
            PG8_BAR; PG8_WAIT_L(0); PG8_MMA(1, 0, At, B0); PG8_BAR; PG8_SCHED;
            PG8_STAGE(PG8_SB(0, 1), b2 + hB, voffB);
            PG8_WAIT_V(6); PG8_BAR; PG8_MMA(1, 1, At, B1); PG8_BAR;
            PG8_LDB(B0, 1, 0); PG8_SCHED; PG8_LDA(At, 1, 0); PG8_STAGE(PG8_SA(0, 1), a2 + hA, voffA);
            PG8_WAIT_L(8); PG8_BAR; PG8_WAIT_L(0); PG8_MMA(0, 0, At, B0); PG8_BAR; PG8_SCHED;
            PG8_LDB(B1, 1, 1); PG8_STAGE(PG8_SB(1, 0), b3, voffB);
            PG8_BAR; PG8_WAIT_L(0); PG8_MMA(0, 1, At, B1); PG8_BAR;
            PG8_LDA(At, 1, 1); PG8_STAGE(PG8_SA(1, 0), a3, voffA);
            PG8_BAR; PG8_WAIT_L(0); PG8_MMA(1, 0, At, B0); PG8_BAR; PG8_SCHED;
            PG8_STAGE(PG8_SB(1, 1), b3 + hB, voffB);
            PG8_WAIT_V(6); PG8_BAR; PG8_MMA(1, 1, At, B1); PG8_BAR;
        }
        if (!PROBE_K2 || (ui & 1)) {
        if constexpr (Epi::NEEDS_RS) {
            if (cur.pm != last_pm) { last_pm = cur.pm;
                if (tid < 256) rsl[tid] = row_rs(E.SS, cur.pm * 256 + tid);
                PG8_WAIT_L(0); PG8_BAR; }
        }
        E(acc, cur, wr, wc, fr, fq, rsl);
        if constexpr (PROBE_EPI2 && Epi::NEEDS_RS) { asm volatile("" ::: "memory"); E(acc, cur, wr, wc, fr, fq, rsl); }
        }
        if (!has_next) break;
#pragma unroll
        for (int a = 0; a < 2; ++a)
#pragma unroll
            for (int b = 0; b < 2; ++b)
#pragma unroll
                for (int m = 0; m < 4; ++m)
#pragma unroll
                    for (int n = 0; n < 2; ++n) acc[a][b][m][n] = (f32x4){0.f, 0.f, 0.f, 0.f};
        cur = nxt; cA = nA; cB = nB; ++ui;
    }
    PG8_WAIT_V(0);
    if (wr == 0) PG8_BAR;
    PG8_BAR;
#undef PG8_SA
#undef PG8_SB
#undef PG8_STAGE
#undef PG8_LDA
#undef PG8_LDB
#undef PG8_MMA
#undef PG8_WAIT_V
#undef PG8_WAIT_L
#undef PG8_BAR
#undef PG8_SCHED
}
}

struct EpiSwiglu {
    static constexpr bool NEEDS_RS = true;
    const float* SS; bf16_t* ACT;
    __device__ __forceinline__ f32x4 act4(float rs, f32x4 g, f32x4 u) const {
        f32x4 a;
#pragma unroll
        for (int j = 0; j < 4; ++j) { const float gg = g[j] * rs, uu = u[j] * rs; a[j] = gg * __builtin_amdgcn_rcpf(1.0f + __expf(-gg)) * uu; }
        return a;
    }
    __device__ __forceinline__ void operator()(const f32x4 (&acc)[2][2][4][2], const pg8::Unit& u, int wr, int wc, int fr, int fq, const LAS float* rsl) const {
#pragma unroll
        for (int ai = 0; ai < 2; ++ai)
#pragma unroll
            for (int m = 0; m < 4; ++m) { const int lr = ai * 128 + wr * 64 + m * 16 + fr, row = u.pm * 256 + lr; const float rs = rsl[lr];
                const u32x2 lo = pack4(act4(rs, acc[ai][0][m][0], acc[ai][0][m][1])), hi = pack4(act4(rs, acc[ai][1][m][0], acc[ai][1][m][1]));
                *(u32x4*)(ACT + (size_t)row * DFF + u.pn * 128 + wc * 32 + 8 * fq) = (u32x4){lo.x, lo.y, hi.x, hi.y}; }
    }
    __device__ __forceinline__ void wtile(int row, int colbase, int fq, const f32x4 (&v)[2]) const {
        const int r = 128 * (colbase >> 8) + 32 * ((colbase >> 5) & 3) + 8 * fq + 4 * ((colbase >> 7) & 1);
        *(u32x2*)(ACT + (size_t)row * DFF + r) = pack4(act4(row_rs(SS, row), v[0], v[1]));
    }
};

__device__ __forceinline__ f32x4 unpack4(u32x2 w) { return (f32x4){bf_lo(w.x), bf_hi(w.x), bf_lo(w.y), bf_hi(w.y)}; }
struct EpiResid {
    static constexpr bool NEEDS_RS = false;
    bf16_t* XB; float* SS;
    __device__ __forceinline__ float oct(int row, int col, u32x4 r, f32x4 a0, f32x4 a1) const {
        const f32x4 x0 = unpack4((u32x2){r.x, r.y}) + a0, x1 = unpack4((u32x2){r.z, r.w}) + a1; const u32x2 p0 = pack4(x0), p1 = pack4(x1);
        *(u32x4*)(XB + (size_t)row * DM + col) = (u32x4){p0.x, p0.y, p1.x, p1.y};
        return ((x0[0] * x0[0] + x0[1] * x0[1]) + (x0[2] * x0[2] + x0[3] * x0[3])) + ((x1[0] * x1[0] + x1[1] * x1[1]) + (x1[2] * x1[2] + x1[3] * x1[3]));
    }
    __device__ __forceinline__ void ldres(u32x4 (&r)[2], const pg8::Unit& u, int g, int wr, int wc, int fr, int fq) const {
        const bf16_t* rp = XB + (size_t)(u.pm * 256 + (g >> 2) * 128 + wr * 64 + (g & 3) * 16 + fr) * DM + u.pn * 256 + wc * 32 + 8 * fq;
#pragma unroll
        for (int bj = 0; bj < 2; ++bj) r[bj] = *(const u32x4*)(rp + bj * 128);
    }
    __device__ __forceinline__ void operator()(const f32x4 (&acc)[2][2][4][2], const pg8::Unit& u, int wr, int wc, int fr, int fq, const LAS float*) const {
        u32x4 r[8][2];
#pragma unroll
        for (int g = 0; g < 6; ++g) ldres(r[g], u, g, wr, wc, fr, fq);
#pragma unroll
        for (int g = 0; g < 8; ++g) { const int ai = g >> 2, m = g & 3, row = u.pm * 256 + ai * 128 + wr * 64 + m * 16 + fr; float ss = 0.f;
#pragma unroll
            for (int bj = 0; bj < 2; ++bj) ss += oct(row, u.pn * 256 + bj * 128 + wc * 32 + 8 * fq, r[g][bj], acc[ai][bj][m][0], acc[ai][bj][m][1]);
            ss += __shfl_xor(ss, 16); ss += __shfl_xor(ss, 32);
            if (fq == 0) SS[(size_t)row * 16 + u.pn * 4 + wc] = ss;
            if (g + 6 < 8) ldres(r[g + 6], u, g + 6, wr, wc, fr, fq); }
    }
    __device__ __forceinline__ void wtile(int row, int colbase, int fq, const f32x4 (&v)[4]) const {
        const bf16_t* rp = XB + (size_t)row * DM + colbase + 8 * fq; u32x4 r[2];
#pragma unroll
        for (int h = 0; h < 2; ++h) r[h] = *(const u32x4*)(rp + 32 * h);
        float ss = oct(row, colbase + 8 * fq, r[0], v[0], v[1]) + oct(row, colbase + 32 + 8 * fq, r[1], v[2], v[3]);
        ss += __shfl_xor(ss, 16); ss += __shfl_xor(ss, 32);
        if (fq == 0) SS[(size_t)row * 16 + (colbase >> 6)] = ss;
    }
};

struct EpiMixIn {
    static constexpr bool NEEDS_RS = true;
    const float* SS; bf16_t *Q, *KB, *VB, *BG, *U; float* out;
    __device__ __forceinline__ void tile2(int row, int colbase, int fq, float rs, f32x4 v0, f32x4 v1) const {
        v0 = v0 * rs; v1 = v1 * rs;
        int b, s; const bool smp = row >= NP;
        if (!smp) { b = row >> 12; s = row & 4095; } else { b = (row - NP) >> 4; s = (row - NP) & 15; }
        if (colbase >= 1280) {
            const int c = ((colbase - 1280) >> 1) + 4 * fq; const f32x4 uu = v0 * v1;
            *(u32x2*)(U + (size_t)row * 512 + c) = pack4(uu);
            if (!smp) { if (s >= SEQL - 2) *(f32x4*)(out + O_CONVP + (size_t)(b * 2 + s - (SEQL - 2)) * 512 + c) = uu; }
            else { if (s >= 14) *(f32x4*)(out + O_CONVS + (size_t)(b * 2 + s - 14) * 512 + c) = uu; }
        } else {
            const int col = colbase + 8 * fq; const u32x2 w0 = pack4(v0), w1 = pack4(v1); const u32x4 w = (u32x4){w0.x, w0.y, w1.x, w1.y};
            if (colbase < 512) *(u32x4*)(Q + (size_t)row * 512 + col) = w;
            else if (colbase < 768) {
                const bool isk = colbase < 640; const int c = col - (isk ? 512 : 640);
                *(u32x4*)((isk ? KB : VB) + (size_t)row * 128 + c) = w;
                float* d = nullptr;
                if (!smp) { if (s >= SEQL - 128) d = out + (isk ? O_KP : O_VP) + (size_t)(b * 128 + s - (SEQL - 128)) * 128 + c; }
                else d = out + (isk ? O_KS : O_VS) + (size_t)(row - NP) * 128 + c;
                if (d) { *(f32x4*)d = v0; *(f32x4*)(d + 4) = v1; }
            } else *(u32x4*)(BG + (size_t)row * 512 + col - 768) = w;
        }
    }
    __device__ __forceinline__ void operator()(const f32x4 (&acc)[2][2][4][2], const pg8::Unit& u, int wr, int wc, int fr, int fq, const LAS float* rsl) const {
#pragma unroll
        for (int ai = 0; ai < 2; ++ai)
#pragma unroll
            for (int m = 0; m < 4; ++m) { const int lr = ai * 128 + wr * 64 + m * 16 + fr, row = u.pm * 256 + lr; const float rs = rsl[lr];
#pragma unroll
                for (int bj = 0; bj < 2; ++bj) tile2(row, u.pn * 256 + bj * 128 + wc * 32, fq, rs, acc[ai][bj][m][0], acc[ai][bj][m][1]); }
    }
    __device__ __forceinline__ void wtile(int row, int colbase, int fq, const f32x4 (&v)[2]) const { tile2(row, colbase, fq, row_rs(SS, row), v[0], v[1]); }
};

template <int NB, int UNR, class Epi>
__device__ __forceinline__ void sgemm(const bf16_t* A, int lda, const bf16_t* Bt, int ldb, int K, int N, const Epi& E, int gw, int nw, int fr, int fq) {
    const int ncb = N / (16 * NB);
    for (int it = gw; it < 8 * ncb; it += nw) {
        const int rb = it & 7, cb = it >> 3, col0 = cb * 16 * NB, row = NP + rb * 16 + fr;
        const bf16_t* ap = A + (size_t)row * lda + fq * 8;
        const bf16_t* bp = Bt + (size_t)(col0 + fr) * ldb + fq * 8;
        f32x4 acc[NB];
#pragma unroll
        for (int n = 0; n < NB; ++n) acc[n] = (f32x4){0.f, 0.f, 0.f, 0.f};
        for (int k = 0; k < K; k += 32 * UNR) {
            bf16x8 a[UNR], b[UNR][NB];
#pragma unroll
            for (int u = 0; u < UNR; ++u) { a[u] = *(const bf16x8*)(ap + k + 32 * u);
#pragma unroll
                for (int n = 0; n < NB; ++n) b[u][n] = *(const bf16x8*)(bp + (size_t)n * 16 * ldb + k + 32 * u); }
#pragma unroll
            for (int u = 0; u < UNR; ++u)
#pragma unroll
                for (int n = 0; n < NB; ++n) acc[n] = __builtin_amdgcn_mfma_f32_16x16x32_bf16(b[u][n], a[u], acc[n], 0, 0, 0);
        }
        E.wtile(row, col0, fq, acc);
    }
}
template <class Epi>
__device__ __forceinline__ void sgemm4_splitk(const int tid, LAS unsigned char* lds, const bf16_t* A, int lda, const bf16_t* Bt, int ldb, int K, int agrp, const Epi& E) {
    const int wave = __builtin_amdgcn_readfirstlane(tid >> 6), lane = tid & 63, fr = lane & 15, fq = lane >> 4, G = gridDim.x;
    for (int it = bidx(); it < 128; it += G) {
        const int rb = it & 7, cb = it >> 3, col0 = cb * 64, row = NP + rb * 16 + fr, kper = K >> 3, kbeg = wave * kper, kend = kbeg + kper;
        const bf16_t* ap = A + (size_t)row * lda + (agrp ? (col0 & ~255) : 0) + fq * 8;
        const bf16_t* bp = Bt + (size_t)(col0 + fr) * ldb + fq * 8;
        f32x4 acc[4];
#pragma unroll
        for (int n = 0; n < 4; ++n) acc[n] = (f32x4){0.f, 0.f, 0.f, 0.f};
        for (int k = kbeg; k < kend; k += 192) {
            bf16x8 a[6], b[6][4];
#pragma unroll
            for (int u = 0; u < 6; ++u) if (k + 32 * u < kend) { a[u] = *(const bf16x8*)(ap + k + 32 * u);
#pragma unroll
                for (int n = 0; n < 4; ++n) b[u][n] = *(const bf16x8*)(bp + (size_t)n * 16 * ldb + k + 32 * u); }
#pragma unroll
            for (int u = 0; u < 6; ++u) if (k + 32 * u < kend) {
#pragma unroll
                for (int n = 0; n < 4; ++n) acc[n] = __builtin_amdgcn_mfma_f32_16x16x32_bf16(b[u][n], a[u], acc[n], 0, 0, 0); }
        }
#pragma unroll
        for (int n = 0; n < 4; ++n) *(LAS f32x4*)(lds + wave * 4096 + n * 1024 + lane * 16) = acc[n];
        __syncthreads();
        if (wave == 0) {
#pragma unroll
            for (int n = 0; n < 4; ++n) { f32x4 t = acc[n];
#pragma unroll
                for (int w = 1; w < 8; ++w) t = t + *(const LAS f32x4*)(lds + w * 4096 + n * 1024 + lane * 16);
                acc[n] = t; }
            E.wtile(row, col0, fq, acc);
        }
        __syncthreads();
    }
}

struct WTile { const float* src0; const float* src1; const float* gp; const float* vs; bf16_t* dst; float cmul; int lds_src, ldd, k0, v0, kind; };
__device__ __forceinline__ WTile wtile_decode(const Params& p, int t) {
    constexpr int T_GU = 4 * 16 * 22, T_WD = 4 * 44 * 4, T_WIN = 16 * 9, T_WOUT = 16 * 4;
    WTile w; w.src1 = nullptr; w.gp = nullptr; w.vs = nullptr; w.cmul = 1.0f;
    if (t < T_GU) { const int f = t / (16 * 22), tt = t % (16 * 22); w.k0 = (tt / 22) * 64; w.v0 = (tt % 22) * 256; w.kind = 1;
        w.src0 = p.w_gate + (size_t)f * DM * DFF; w.src1 = p.w_up + (size_t)f * DM * DFF; w.gp = p.norm_g + ((f >> 1) * 3 + ((f & 1) ? 2 : 0)) * DM; w.lds_src = DFF; w.ldd = DM; w.dst = (bf16_t*)(p.ws + WS_WGU) + (size_t)f * 5632 * DM; }
    else if (t < T_GU + T_WD) { const int t2 = t - T_GU, f = t2 / (44 * 4), tt = t2 % (44 * 4); w.k0 = (tt / 4) * 64; w.v0 = (tt % 4) * 256; w.kind = 0;
        w.src0 = p.w_down + (size_t)f * DFF * DM; w.cmul = 0.5f; w.lds_src = DM; w.ldd = DFF; w.dst = (bf16_t*)(p.ws + WS_WD) + (size_t)f * DM * DFF; }
    else if (t < T_GU + T_WD + T_WIN) { const int tt = t - T_GU - T_WD; w.k0 = (tt / 9) * 64; w.v0 = (tt % 9) * 256; w.kind = 2;
        w.src0 = p.mix_w_in; w.gp = p.norm_g + 1 * DM; w.lds_src = 2304; w.ldd = DM; w.dst = (bf16_t*)(p.ws + WS_WIN); }
    else if (t < T_GU + T_WD + T_WIN + T_WOUT) { const int tt = t - T_GU - T_WD - T_WIN; w.k0 = (tt / 4) * 64; w.v0 = (tt % 4) * 256; w.kind = 0;
        w.src0 = p.mix_w_out; w.lds_src = DM; w.ldd = DM; w.dst = (bf16_t*)(p.ws + WS_WOUT); }
    else { const int t2 = t - T_GU - T_WD - T_WIN - T_WOUT, gi = t2 >> 2, tt = t2 & 3; w.k0 = tt * 64; w.v0 = 0; w.kind = 0;
        w.src0 = p.pool_w + (size_t)gi * 65536; w.vs = p.pool_scale + gi * 256; w.lds_src = 256; w.ldd = 256; w.dst = (bf16_t*)(p.ws + WS_WP) + (size_t)gi * 65536; }
    return w;
}
__device__ __forceinline__ void wtile_load(const WTile& w, int tid, f32x4 (&q)[8]) {
#pragma unroll
    for (int i = 0; i < 8; ++i) { const int e = tid + 512 * i, kr = e >> 6, v = w.v0 + (e & 63) * 4; const float* sp = w.src0; int col = v;
        if (w.kind == 1) { col = 128 * (v >> 8) + 32 * ((v >> 5) & 3) + 8 * ((v >> 2) & 3) + 4 * ((v >> 7) & 1); if ((v >> 4) & 1) sp = w.src1; }
        else if (w.kind == 2) { if (v >= 1280) { const int x = v - 1280, j = x >> 5, ii = x & 31; col = ii < 16 ? 1280 + 16 * j + ii : 1792 + 16 * j + ii - 16; }
                                else { const int rho = v & 31; col = (v & ~31) + 8 * ((rho & 15) >> 2) + 4 * (rho >> 4); } }
        if (w.kind == 0) { const int rho = v & 31; col = (v & ~31) + 8 * ((rho & 15) >> 2) + 4 * (rho >> 4); }
        q[i] = __builtin_nontemporal_load((const f32x4*)(sp + (size_t)(w.k0 + kr) * w.lds_src + col)); if (w.gp) q[i] = q[i] * w.gp[w.k0 + kr]; if (w.vs) q[i] = q[i] * *(const f32x4*)(w.vs + col); q[i] = q[i] * w.cmul; }
}
__device__ __forceinline__ int late_tile(int j) {
    if (j < 352) return 352 + j;
    if (j < 528) return 1408 + 176 + (j - 352);
    if (j < 880) return 704 + (j - 528);
    if (j < 1056) return 1408 + 352 + (j - 880);
    if (j < 1408) return 1056 + (j - 1056);
    if (j < 1584) return 1408 + 528 + (j - 1408);
    return 2320 + (j - 1584);
}
constexpr int LATE_MIXIN = 640, LATE_ATTN = 1120, LATE_ALL = 1600, PRO_EARLY = 736;
__device__ __forceinline__ int pro_tile(int q) {
    if (q < 352) return q;
    if (q < 528) return 1408 + (q - 352);
    if (q < 672) return 2112 + (q - 528);
    if (q < 736) return 2256 + (q - 672);
    return late_tile(LATE_ATTN + (q - PRO_EARLY));
}
__device__ __forceinline__ void convert_range(const int tid, const Params& p, LAS unsigned char* lds, int first, int end, int stride, bool late) {
    LAS float* T = (LAS float*)lds;
    if (first >= end) return;
    f32x4 q[8]; int i = first; WTile cur = wtile_decode(p, late ? late_tile(i) : pro_tile(i));
    wtile_load(cur, tid, q);
    for (; i < end; i += stride) {
        __syncthreads();
#pragma unroll
        for (int k = 0; k < 8; ++k) { const int e = tid + 512 * k, kr = e >> 6, vv = (e & 63) * 4;
            T[kr * 257 + vv] = q[k][0]; T[kr * 257 + vv + 1] = q[k][1]; T[kr * 257 + vv + 2] = q[k][2]; T[kr * 257 + vv + 3] = q[k][3]; }
        bf16_t* dst = cur.dst; const int ldd = cur.ldd, k0 = cur.k0, v0 = cur.v0;
        if (i + stride < end) { cur = wtile_decode(p, late ? late_tile(i + stride) : pro_tile(i + stride)); wtile_load(cur, tid, q); }
        __syncthreads();
#pragma unroll
        for (int k = 0; k < 4; ++k) { const int e = tid + 512 * k, kq = (e & 7) * 8, vv = e >> 3;
            u32x4 wv; wv.x = cvt_pk_bf16(T[kq * 257 + vv], T[(kq + 1) * 257 + vv]); wv.y = cvt_pk_bf16(T[(kq + 2) * 257 + vv], T[(kq + 3) * 257 + vv]);
            wv.z = cvt_pk_bf16(T[(kq + 4) * 257 + vv], T[(kq + 5) * 257 + vv]); wv.w = cvt_pk_bf16(T[(kq + 6) * 257 + vv], T[(kq + 7) * 257 + vv]);
            *(u32x4*)(dst + (size_t)(v0 + vv) * ldd + k0 + kq) = wv; }
    }
}
__device__ __forceinline__ void prologue_phase(const int tid, const Params& p, LAS unsigned char* lds) {
    const int G = gridDim.x;
    convert_range(tid, p, lds, (int)bidx(), PRO_EARLY + (LATE_ALL - LATE_ATTN), G, false);
    const int lane = tid & 63, gw = (tid >> 6) * G + bidx(), nw = 8 * G;
    bf16_t* XB = (bf16_t*)(p.ws + WS_XB); float* SS = (float*)(p.ws + WS_SS);
    for (int r0 = gw; r0 < NR; r0 += 4 * nw) {
        f32x4 x[4][4];
#pragma unroll
        for (int r = 0; r < 4; ++r) { const int row = r0 + r * nw; if (row < NR) { const float* xp = row < NP ? p.x_prompt + (size_t)row * DM : p.x_sample + (size_t)(row - NP) * DM;
#pragma unroll
            for (int j = 0; j < 4; ++j) x[r][j] = __builtin_nontemporal_load((const f32x4*)(xp + lane * 8 + 512 * (j >> 1) + 4 * (j & 1))); } }
#pragma unroll
        for (int r = 0; r < 4; ++r) { const int row = r0 + r * nw; if (row < NR) { float ss = 0.f;
#pragma unroll
            for (int j = 0; j < 4; ++j) { const f32x4 v = x[r][j]; ss += (v[0] * v[0] + v[1] * v[1]) + (v[2] * v[2] + v[3] * v[3]); }
#pragma unroll
            for (int h = 0; h < 2; ++h) { const u32x2 a = pack4(x[r][2 * h]), b2 = pack4(x[r][2 * h + 1]); *(u32x4*)(XB + (size_t)row * DM + lane * 8 + 512 * h) = (u32x4){a.x, a.y, b2.x, b2.y}; }
#pragma unroll
            for (int o = 32; o >= 1; o >>= 1) ss += __shfl_xor(ss, o);
            if (lane < 16) SS[(size_t)row * 16 + lane] = lane == 0 ? ss : 0.f; } }
    }
}

__device__ __forceinline__ void attn_phase(const int tid, const Params& p, LAS unsigned char* lds) {
    LAS bf16_t* Ks = (LAS bf16_t*)lds;
    LAS bf16_t* Vt = (LAS bf16_t*)(lds + 27648);
    LAS float* TB = (LAS float*)(lds + 53248);
    const int wave = __builtin_amdgcn_readfirstlane(tid >> 6), lane = tid & 63, fr = lane & 15, fq = lane >> 4, G = gridDim.x;
    const bf16_t* Q = (const bf16_t*)(p.ws + WS_Q); const bf16_t* KB = (const bf16_t*)(p.ws + WS_KB); const bf16_t* VB = (const bf16_t*)(p.ws + WS_VB);
    const bf16_t* BG = (const bf16_t*)(p.ws + WS_BG); const bf16_t* U = (const bf16_t*)(p.ws + WS_U); bf16_t* MIX = (bf16_t*)(p.ws + WS_MIX);
    for (int i = tid; i < 8 * 256; i += 512) { const int h = i >> 8, rel = (i & 255) - 191, n = rel < 0 ? -rel : rel;
        int bk = n; if (n >= 8) { bk = 2 + (31 - __clz(n * n)); bk = bk > 15 ? 15 : bk; }
        bk += rel > 0 ? 16 : 0; TB[i] = p.rel_table[bk * 8 + h]; }
    for (int item = bidx(); item < 1040; item += G) {
        const bool smp = item >= 1024; int b, kvh, rowbase, kk_lo, kk_hi;
        if (!smp) { kvh = item & 1; const int c = (item >> 1) & 63; b = item >> 7; rowbase = b * SEQL + c * 64; kk_lo = 128 - c * 64; kk_lo = kk_lo < 0 ? 0 : kk_lo; kk_hi = 192; }
        else { const int i2 = item - 1024; kvh = i2 & 1; b = i2 >> 1; rowbase = NP + b * 16; kk_lo = 0; kk_hi = 144; }
        const int nunits = smp ? 4 : 16;
        bf16x8 qn[2];
        if (wave < nunits) { const int g0 = smp ? wave : (wave >> 2), qb0 = smp ? 0 : (wave & 3); const size_t qr0 = (size_t)rowbase + qb0 * 16 + fr;
#pragma unroll
            for (int ks = 0; ks < 2; ++ks) qn[ks] = *(const bf16x8*)(Q + qr0 * 512 + (kvh * 4 + g0) * 64 + ks * 32 + fq * 8); }
        const bool full = (kk_lo == 0 && kk_hi == 192);
        __syncthreads();
        u32x4 kvr[3], vvr[3];
#pragma unroll
        for (int it = 0; it < 3; ++it) { const int ch = tid + 512 * it, kk = ch >> 3, d8 = (ch & 7) * 8; u32x4 kv = (u32x4){0u, 0u, 0u, 0u}, vv = kv;
            if (kk >= kk_lo && kk < kk_hi) {
                if (smp && kk < 128) { const size_t o = ((size_t)(b * 128 + kk) * 2 + kvh) * 64 + d8;
                    const f32x4 k0 = *(const f32x4*)(p.cache_k + o), k1 = *(const f32x4*)(p.cache_k + o + 4), w0 = *(const f32x4*)(p.cache_v + o), w1 = *(const f32x4*)(p.cache_v + o + 4);
                    const u32x2 a = pack4(k0), bb = pack4(k1), c = pack4(w0), d = pack4(w1); kv = (u32x4){a.x, a.y, bb.x, bb.y}; vv = (u32x4){c.x, c.y, d.x, d.y}; }
                else { const size_t row = smp ? (size_t)(rowbase + kk - 128) : (size_t)(rowbase - 128 + kk);
                    kv = *(const u32x4*)(KB + row * 128 + kvh * 64 + d8); vv = *(const u32x4*)(VB + row * 128 + kvh * 64 + d8); } }
            kvr[it] = kv; vvr[it] = vv; }
#pragma unroll
        for (int it = 0; it < 3; ++it) { const int ch = tid + 512 * it, kk = ch >> 3, d8 = (ch & 7) * 8; const u32x4 kv = kvr[it], vv = vvr[it];
            *(LAS u32x4*)(Ks + kk * 72 + d8) = kv;
            Vt[(d8 + 0) * 200 + kk] = (bf16_t)(vv.x & 0xffffu); Vt[(d8 + 1) * 200 + kk] = (bf16_t)(vv.x >> 16);
            Vt[(d8 + 2) * 200 + kk] = (bf16_t)(vv.y & 0xffffu); Vt[(d8 + 3) * 200 + kk] = (bf16_t)(vv.y >> 16);
            Vt[(d8 + 4) * 200 + kk] = (bf16_t)(vv.z & 0xffffu); Vt[(d8 + 5) * 200 + kk] = (bf16_t)(vv.z >> 16);
            Vt[(d8 + 6) * 200 + kk] = (bf16_t)(vv.w & 0xffffu); Vt[(d8 + 7) * 200 + kk] = (bf16_t)(vv.w >> 16); }
        __syncthreads();
        for (int un = wave; un < nunits; un += 8) {
            const int g = smp ? un : (un >> 2), qb = smp ? 0 : (un & 3), head = kvh * 4 + g, qi = qb * 16 + fr; const size_t qrow = (size_t)rowbase + qi;
            bf16x8 qf[2]; qf[0] = qn[0]; qf[1] = qn[1];
            if (un + 8 < nunits) { const int un2 = un + 8, g2 = un2 >> 2, qb2 = un2 & 3; const size_t qr2 = (size_t)rowbase + qb2 * 16 + fr;
#pragma unroll
                for (int ks = 0; ks < 2; ++ks) qn[ks] = *(const bf16x8*)(Q + qr2 * 512 + (kvh * 4 + g2) * 64 + ks * 32 + fq * 8); }
            f32x4 s[12];
#pragma unroll
            for (int kb = 0; kb < 12; ++kb) { s[kb] = (f32x4){0.f, 0.f, 0.f, 0.f};
#pragma unroll
                for (int ks = 0; ks < 2; ++ks) { const bf16x8 a = *(const LAS bf16x8*)(Ks + (kb * 16 + fr) * 72 + ks * 32 + fq * 8); s[kb] = __builtin_amdgcn_mfma_f32_16x16x32_bf16(a, qf[ks], s[kb], 0, 0, 0); } }
            const float sink = p.sinks[head]; float mx = sink;
#pragma unroll
            for (int kb = 0; kb < 12; ++kb)
#pragma unroll
                for (int j = 0; j < 4; ++j) { const int kk = kb * 16 + 4 * fq + j; float v = s[kb][j] * 0.125f + TB[head * 256 + kk - 128 - qi + 191];
                    if (!full && (kk < kk_lo || kk >= kk_hi)) v = -1e30f; s[kb][j] = v; mx = fmaxf(mx, v); }
            mx = fmaxf(mx, __shfl_xor(mx, 16)); mx = fmaxf(mx, __shfl_xor(mx, 32));
            float sum = 0.f;
#pragma unroll
            for (int kb = 0; kb < 12; ++kb)
#pragma unroll
                for (int j = 0; j < 4; ++j) { const float e = __expf(s[kb][j] - mx); s[kb][j] = e; sum += e; }
            sum += __shfl_xor(sum, 16); sum += __shfl_xor(sum, 32);
            const float inv = 1.0f / (sum + __expf(sink - mx));
            bf16x8 pf[6];
#pragma unroll
            for (int k2 = 0; k2 < 6; ++k2) { const u32x2 a = pack4(s[2 * k2] * inv), c = pack4(s[2 * k2 + 1] * inv); const u32x4 w = (u32x4){a.x, a.y, c.x, c.y}; pf[k2] = __builtin_bit_cast(bf16x8, w); }
            int zv = 0; asm volatile("" : "+v"(zv));
#pragma unroll
            for (int db = 0; db < 4; ++db) { f32x4 o = (f32x4){0.f, 0.f, 0.f, 0.f};
#pragma unroll
                for (int k2 = 0; k2 < 6; ++k2) { const LAS bf16_t* vp = Vt + (db * 16 + fr) * 200 + 32 * k2 + 4 * fq + zv; const u32x2 a0 = *(const LAS u32x2*)vp, a1 = *(const LAS u32x2*)(vp + 16);
                    const u32x4 w = (u32x4){a0.x, a0.y, a1.x, a1.y}; o = __builtin_amdgcn_mfma_f32_16x16x32_bf16(__builtin_bit_cast(bf16x8, w), pf[k2], o, 0, 0, 0); }
                *(u32x2*)(MIX + qrow * 1024 + head * 64 + db * 16 + 4 * fq) = pack4(o); }
        }
    }
    {
        const int c = (tid & 63) * 8, rsub = tid >> 6, nrb = NR / 8;
        float w0[8], w1[8], w2[8];
#pragma unroll
        for (int j = 0; j < 8; ++j) { w0[j] = p.conv_w[c + j]; w1[j] = p.conv_w[512 + c + j]; w2[j] = p.conv_w[1024 + c + j]; }
        for (int rb0 = bidx(); rb0 < nrb; rb0 += 4 * G) {
            u32x4 a0[4], a1[4], a2[4], ab[4]; bool ok[4];
#pragma unroll
            for (int r = 0; r < 4; ++r) { const int rb = rb0 + r * G; ok[r] = rb < nrb; if (ok[r]) { const int row = rb * 8 + rsub; const bool smp = row >= NP; const int s1 = smp ? ((row - NP) & 15) : (row & 4095);
                a0[r] = *(const u32x4*)(U + (size_t)row * 512 + c); ab[r] = *(const u32x4*)(BG + (size_t)row * 512 + c);
                if (s1 >= 1) a1[r] = *(const u32x4*)(U + (size_t)(row - 1) * 512 + c);
                if (s1 >= 2) a2[r] = *(const u32x4*)(U + (size_t)(row - 2) * 512 + c); } }
#pragma unroll
            for (int r = 0; r < 4; ++r) if (ok[r]) { const int row = (rb0 + r * G) * 8 + rsub; const bool smp = row >= NP; int b, s1; if (!smp) { b = row >> 12; s1 = row & 4095; } else { b = (row - NP) >> 4; s1 = (row - NP) & 15; }
                float u0[8], u1[8], u2[8], bg[8];
                { const u32x4 w = a0[r]; u0[0] = bf_lo(w.x); u0[1] = bf_hi(w.x); u0[2] = bf_lo(w.y); u0[3] = bf_hi(w.y); u0[4] = bf_lo(w.z); u0[5] = bf_hi(w.z); u0[6] = bf_lo(w.w); u0[7] = bf_hi(w.w); }
                { const u32x4 w = ab[r]; bg[0] = bf_lo(w.x); bg[1] = bf_hi(w.x); bg[2] = bf_lo(w.y); bg[3] = bf_hi(w.y); bg[4] = bf_lo(w.z); bg[5] = bf_hi(w.z); bg[6] = bf_lo(w.w); bg[7] = bf_hi(w.w); }
                if (s1 >= 1) { const u32x4 w = a1[r]; u1[0] = bf_lo(w.x); u1[1] = bf_hi(w.x); u1[2] = bf_lo(w.y); u1[3] = bf_hi(w.y); u1[4] = bf_lo(w.z); u1[5] = bf_hi(w.z); u1[6] = bf_lo(w.w); u1[7] = bf_hi(w.w); }
                else {
#pragma unroll
                    for (int j = 0; j < 8; ++j) u1[j] = smp ? p.cache_conv[(size_t)(b * 2 + 1) * 512 + c + j] : 0.f; }
                if (s1 >= 2) { const u32x4 w = a2[r]; u2[0] = bf_lo(w.x); u2[1] = bf_hi(w.x); u2[2] = bf_lo(w.y); u2[3] = bf_hi(w.y); u2[4] = bf_lo(w.z); u2[5] = bf_hi(w.z); u2[6] = bf_lo(w.w); u2[7] = bf_hi(w.w); }
                else {
#pragma unroll
                    for (int j = 0; j < 8; ++j) u2[j] = smp ? p.cache_conv[(size_t)(b * 2 + s1) * 512 + c + j] : 0.f; }
                float y[8];
#pragma unroll
                for (int j = 0; j < 8; ++j) y[j] = bg[j] * (w0[j] * u2[j] + w1[j] * u1[j] + w2[j] * u0[j]);
                u32x4 w; w.x = cvt_pk_bf16(y[0], y[1]); w.y = cvt_pk_bf16(y[2], y[3]); w.z = cvt_pk_bf16(y[4], y[5]); w.w = cvt_pk_bf16(y[6], y[7]);
                *(u32x4*)(MIX + (size_t)row * 1024 + 512 + c) = w; }
        }
    }
    { const int nx = 1040 % G, cw = (int)bidx(); if (cw >= nx) convert_range(tid, p, lds, LATE_MIXIN + cw - nx, LATE_ATTN, G - nx, true); }
}

__device__ __forceinline__ f32x4 pool_h(const Params& p, const bf16_t* X, const LAS float* rsl, bool smp, int b, int seqrow0, int t0, int t, int col, f32x4 g4) {
    if (t < 0) { if (!smp) return (f32x4){0.f, 0.f, 0.f, 0.f}; return *(const f32x4*)(p.cache_pool + (size_t)(b * 15 + 15 + t) * DM + col); }
    const float r = rsl[t - t0 + 16]; const f32x4 x = unpack4(*(const u32x2*)(X + (size_t)(seqrow0 + t) * DM + col)); return x * r * g4;
}
__device__ __forceinline__ void pooldiff_phase(const int tid, const Params& p, LAS unsigned char* lds) {
    LAS float* RS = (LAS float*)lds;
    const int half = tid >> 8, tl = tid & 255, G = gridDim.x;
    const bf16_t* X = (const bf16_t*)(p.ws + WS_XB); const float* SS = (const float*)(p.ws + WS_SS); bf16_t* D = (bf16_t*)(p.ws + WS_MIX);
    const int col = tl * 4, w = 2 << (col >> 8); const f32x4 g4 = *(const f32x4*)(p.norm_g + 4 * DM + col); const float invw = 1.0f / (float)w;
    for (int item = bidx(); item < 256 + 4; item += G) {
        const bool smp = item >= 256; int b, t0, nrows, seqrow0, T0;
        if (!smp) { const int blk = item * 2 + half; b = blk >> 6; t0 = (blk & 63) * 64; nrows = 64; seqrow0 = b * SEQL; T0 = 0; }
        else { b = (item - 256) * 2 + half; t0 = 0; nrows = 16; seqrow0 = NP + b * 16; T0 = 1024; }
        __syncthreads();
        if (tl < 80) { const int t = t0 - 16 + tl; if (t >= 0 && t < t0 + nrows) RS[half * 80 + tl] = row_rs(SS, seqrow0 + t); }
        __syncthreads();
        const LAS float* rsl = RS + half * 80;
        f32x4 hh[15];
#pragma unroll
        for (int j = 1; j < 16; ++j) if (j < w) hh[j - 1] = pool_h(p, X, rsl, smp, b, seqrow0, t0, t0 - j, col, g4);
        f32x4 sp = (f32x4){0.f, 0.f, 0.f, 0.f};
#pragma unroll
        for (int j = 1; j < 16; ++j) if (j < w) sp = sp + hh[j - 1];
        for (int tb = t0; tb < t0 + nrows; tb += 16) {
            f32x4 h8[16], o8[16];
#pragma unroll
            for (int j = 0; j < 16; ++j) { h8[j] = pool_h(p, X, rsl, smp, b, seqrow0, t0, tb + j, col, g4); o8[j] = pool_h(p, X, rsl, smp, b, seqrow0, t0, tb + j - w + 1, col, g4); }
#pragma unroll
            for (int j = 0; j < 16; ++j) { const int t = tb + j; const f32x4 h = h8[j]; const f32x4 s = sp + h;
                const int cnt = (T0 + t + 1) < w ? (T0 + t + 1) : w; const float ic = cnt == w ? invw : 1.0f / (float)cnt;
                const f32x4 d = s * ic - h;
                *(u32x2*)(D + (size_t)(seqrow0 + t) * DM + col) = pack4(d);
                sp = s - o8[j];
                if (!smp) { if (t >= SEQL - 15) *(f32x4*)(p.out + O_POOLP + (size_t)(b * 15 + t - (SEQL - 15)) * DM + col) = h; }
                else { if (t >= 1) *(f32x4*)(p.out + O_POOLS + (size_t)(b * 15 + t - 1) * DM + col) = h; } }
        }
    }
}

__device__ __forceinline__ void final_phase(const int tid, const Params& p) {
    const int lane = tid & 63, G = gridDim.x, gw = (tid >> 6) * G + bidx(), nw = 8 * G;
    const bf16_t* X = (const bf16_t*)(p.ws + WS_XB); const float* SS = (const float*)(p.ws + WS_SS);
    f32x4 g[4];
#pragma unroll
    for (int j = 0; j < 4; ++j) g[j] = *(const f32x4*)(p.final_g + lane * 4 + 256 * j);
    for (int r0 = gw; r0 < NR; r0 += 4 * nw) {
        f32x4 x[4][4]; float rs[4];
#pragma unroll
        for (int r = 0; r < 4; ++r) { const int row = r0 + r * nw; if (row < NR) { rs[r] = row_rs(SS, row);
#pragma unroll
            for (int j = 0; j < 4; ++j) x[r][j] = unpack4(*(const u32x2*)(X + (size_t)row * DM + lane * 4 + 256 * j)); } }
#pragma unroll
        for (int r = 0; r < 4; ++r) { const int row = r0 + r * nw; if (row < NR) { float* dst = row < NP ? p.out + O_YP + (size_t)row * DM : p.out + O_YS + (size_t)(row - NP) * DM;
#pragma unroll
            for (int j = 0; j < 4; ++j) __builtin_nontemporal_store(x[r][j] * rs[r] * g[j], (f32x4*)(dst + lane * 4 + 256 * j)); } }
    }
}

__device__ __forceinline__ void grid_bar(unsigned* bar, unsigned k) {
    asm volatile("s_waitcnt vmcnt(0)" ::: "memory");
    __syncthreads();
    if (threadIdx.x == 0) {
        const unsigned g = bidx() & 7u, per = (gridDim.x + 7u - g) >> 3, ngrp = gridDim.x < 8u ? gridDim.x : 8u;
        __builtin_amdgcn_fence(__ATOMIC_RELEASE, "agent");
        asm volatile("s_waitcnt vmcnt(0)" ::: "memory");
        const unsigned old = __hip_atomic_fetch_add(bar + 64 * g, 1u, __ATOMIC_RELAXED, __HIP_MEMORY_SCOPE_AGENT);
        if (old + 1u == per * k) {
            const unsigned ot = __hip_atomic_fetch_add(bar + 64 * 8, 1u, __ATOMIC_RELAXED, __HIP_MEMORY_SCOPE_AGENT);
            if (ot + 1u == ngrp * k) {
#pragma unroll
                for (int j = 0; j < 8; ++j) __hip_atomic_store(bar + 64 * (9 + j), k, __ATOMIC_RELAXED, __HIP_MEMORY_SCOPE_AGENT);
            }
        }
        while (__hip_atomic_load(bar + 64 * (9 + g), __ATOMIC_RELAXED, __HIP_MEMORY_SCOPE_AGENT) < k) __builtin_amdgcn_s_sleep(1);
        __builtin_amdgcn_fence(__ATOMIC_ACQUIRE, "agent");
        asm volatile("s_waitcnt vmcnt(0)" ::: "memory");
    }
    __syncthreads();
}

enum { K_PRO = 0, K_G1, K_RES, K_MIXIN, K_ATTN, K_PDIFF, K_FINAL, K_DUMP };
#ifndef DBG_LAST
#define DBG_LAST -1
#endif
__device__ __forceinline__ void dump_phase(const int tid, const Params& p) {
    const int G = gridDim.x; const size_t gt = (size_t)bidx() * 512 + tid, nt = (size_t)G * 512;
    const bf16_t* XB = (const bf16_t*)(p.ws + WS_XB); const float* SS = (const float*)(p.ws + WS_SS);
#if DBG_LAST == 3 || DBG_LAST == 4
    const bf16_t* AR = (const bf16_t*)(p.ws + WS_ACT);
    for (size_t i = gt; i < (size_t)NR * DM; i += nt) { float v = __uint_as_float((unsigned)AR[i] << 16) + __uint_as_float((unsigned)AR[i + (size_t)NR * DM] << 16); if (i < (size_t)NR * 768) v += __uint_as_float((unsigned)AR[i + (size_t)2 * NR * DM] << 16); p.out[i] = v; }
#else
    for (size_t i = gt; i < (size_t)NR * DM; i += nt) { const int row = (int)(i >> 10); p.out[i] = __uint_as_float((unsigned)XB[i] << 16) * row_rs(SS, row); }
#endif
    for (size_t i = (size_t)NR * DM + gt; i < O_POOLS + 122880; i += nt) p.out[i] = 0.f;
}
__global__ void __launch_bounds__(512, 2) mk_fwd(Params pk) {
    extern __shared__ __attribute__((aligned(16))) unsigned char smem[];
    LAS unsigned char* lds = (LAS unsigned char*)smem;
    const int G = gridDim.x;
    unsigned nbar = 0;
    if (pk.ph_lo < 0) cg::this_grid().sync();
    for (int ph = pk.ph_lo; ph < pk.ph_hi; ++ph)
    for (int rep = 0; rep < 1 + ((PROBE_DUP >> ph) & 1); ++rep) {
        int tid = threadIdx.x; asm volatile("" : "+v"(tid));
        Params p = pk; { size_t z = 0; asm volatile("" : "+s"(z)); p.ws = pk.ws + z; p.out = pk.out + z; }
        bf16_t* XB = (bf16_t*)(p.ws + WS_XB); float* SS = (float*)(p.ws + WS_SS); bf16_t* ACT = (bf16_t*)(p.ws + WS_ACT); bf16_t* MIX = (bf16_t*)(p.ws + WS_MIX);
        int kind, f = 0;
        switch (ph) {
            case 0: kind = K_PRO; break;
            case 1: kind = K_G1; f = 0; break;   case 2: kind = K_RES; f = 0; break;
            case 3: kind = K_MIXIN; break;       case 4: kind = K_ATTN; break;       case 5: kind = K_RES; f = 4; break;
            case 6: kind = K_G1; f = 1; break;   case 7: kind = K_RES; f = 1; break;
            case 8: kind = K_G1; f = 2; break;   case 9: kind = K_RES; f = 2; break;
            case 10: kind = K_PDIFF; break;      case 11: kind = K_RES; f = 5; break;
            case 12: kind = K_G1; f = 3; break;  case 13: kind = K_RES; f = 3; break;
            case 14: kind = K_FINAL; break;
            default: kind = K_DUMP; break;
        }
        if (kind == K_PRO) prologue_phase(tid, p, lds);
        else if (kind == K_G1) {
            const bf16_t* W = (const bf16_t*)(p.ws + WS_WGU) + (size_t)f * 5632 * DM;
            EpiSwiglu E{SS, ACT};
            { const int lane = tid & 63; sgemm<2, 4>(XB, DM, W, DM, DM, 5632, E, __builtin_amdgcn_readfirstlane(tid >> 6) * G + bidx(), 8 * G, lane & 15, lane >> 4); }
            pg8::Gemm g{XB, W, 128, 22, DM, DM, DM, 0}; pg8::StaticOrder S; S.init(128, 22, G, (int)bidx());
            pg8::gemm_phase(tid, lds, g, S, E);
        } else if (kind == K_RES) {
            pg8::Gemm g; EpiResid E; E.XB = XB; E.SS = SS; int K, agrp = 0;
            if (f < 4) { g = pg8::Gemm{ACT, (const bf16_t*)(p.ws + WS_WD) + (size_t)f * DM * DFF, 128, 4, DFF, DFF, DFF, 0}; K = DFF; }
            else if (f == 4) { g = pg8::Gemm{MIX, (const bf16_t*)(p.ws + WS_WOUT), 128, 4, DM, DM, DM, 0}; K = DM; }
            else { g = pg8::Gemm{MIX, (const bf16_t*)(p.ws + WS_WP), 128, 4, 256, DM, 256, 256}; K = 256; agrp = 1; }
            sgemm4_splitk(tid, lds, g.A, g.lda, g.Bt, g.ldb, K, agrp, E);
            pg8::StaticOrder S; S.init(128, 4, G, (int)bidx());
            pg8::gemm_phase(tid, lds, g, S, E);
        } else if (kind == K_MIXIN) {
            const bf16_t* W = (const bf16_t*)(p.ws + WS_WIN);
            EpiMixIn E{SS, (bf16_t*)(p.ws + WS_Q), (bf16_t*)(p.ws + WS_KB), (bf16_t*)(p.ws + WS_VB), (bf16_t*)(p.ws + WS_BG), (bf16_t*)(p.ws + WS_U), p.out};
            { const int lane = tid & 63; sgemm<2, 4>(XB, DM, W, DM, DM, 2304, E, __builtin_amdgcn_readfirstlane(tid >> 6) * G + bidx(), 8 * G, lane & 15, lane >> 4); }
            pg8::Gemm g{XB, W, 128, 9, DM, DM, DM, 0}; pg8::StaticOrder S; S.init(128, 9, G, (int)bidx());
            pg8::gemm_phase(tid, lds, g, S, E);
            { const int nx = 1152 % G, c = (int)bidx(); if (c >= nx) convert_range(tid, p, lds, c - nx, LATE_MIXIN, G - nx, true); }
        } else if (kind == K_ATTN) attn_phase(tid, p, lds);
        else if (kind == K_PDIFF) pooldiff_phase(tid, p, lds);
        else if (kind == K_DUMP) dump_phase(tid, p);
        else final_phase(tid, p);
        if (ph + 1 < pk.ph_hi || rep < ((PROBE_DUP >> ph) & 1)) { grid_bar((unsigned*)(pk.ws + WS_BAR), nbar + 1);
            if (PROBE_SYNC) { ++nbar; grid_bar((unsigned*)(pk.ws + WS_BAR), nbar + 1); ++nbar; grid_bar((unsigned*)(pk.ws + WS_BAR), nbar + 1); }
            ++nbar; }
    }
}

extern "C" void kernel_launch(void* const* d_in, const int* in_sizes, int n_in, void* d_out, int out_size, void* d_ws, size_t ws_size, hipStream_t stream) {
    static int grid = 0;
    if (grid == 0) {
        if (ws_size < WS_END) { fprintf(stderr, "kernel_launch: workspace too small: %zu < %zu\n", ws_size, (size_t)WS_END); grid = -1; return; }
        if (hipFuncSetAttribute((const void*)mk_fwd, hipFuncAttributeMaxDynamicSharedMemorySize, LDS_BYTES) != hipSuccess) { fprintf(stderr, "kernel_launch: hipFuncSetAttribute failed\n"); grid = -1; return; }
        int dev = 0, cus = 0, per_cu = 0;
        (void)hipGetDevice(&dev); (void)hipDeviceGetAttribute(&cus, hipDeviceAttributeMultiprocessorCount, dev);
        (void)hipOccupancyMaxActiveBlocksPerMultiprocessor(&per_cu, (const void*)mk_fwd, 512, LDS_BYTES);
        if (per_cu < 1) { fprintf(stderr, "kernel_launch: occupancy query says %d blocks per CU\n", per_cu); per_cu = 1; }
        (void)hipGetLastError();
        grid = cus;
    }
    if (grid < 0) return;
    Params p{};
    p.x_prompt = (const float*)d_in[0]; p.x_sample = (const float*)d_in[1]; p.cache_k = (const float*)d_in[2]; p.cache_v = (const float*)d_in[3]; p.cache_conv = (const float*)d_in[4]; p.cache_pool = (const float*)d_in[5];
    p.norm_g = (const float*)d_in[6]; p.w_gate = (const float*)d_in[7]; p.w_up = (const float*)d_in[8]; p.w_down = (const float*)d_in[9]; p.mix_w_in = (const float*)d_in[10]; p.mix_w_out = (const float*)d_in[11];
    p.conv_w = (const float*)d_in[12]; p.sinks = (const float*)d_in[13]; p.rel_table = (const float*)d_in[14]; p.pool_w = (const float*)d_in[15]; p.pool_scale = (const float*)d_in[16]; p.final_g = (const float*)d_in[17];
    p.out = (float*)d_out; p.ws = (unsigned char*)d_ws;
#if MK_MULTI
#if DBG_LAST >= 0
    for (int ph = 0; ph <= DBG_LAST; ++ph) { p.ph_lo = ph; p.ph_hi = ph + 1; hipLaunchKernelGGL(mk_fwd, dim3(grid), dim3(512), LDS_BYTES, stream, p); }
    p.ph_lo = 15; p.ph_hi = 16; hipLaunchKernelGGL(mk_fwd, dim3(grid), dim3(512), LDS_BYTES, stream, p);
#else
    for (int ph = 0; ph < NPH; ++ph) { p.ph_lo = ph; p.ph_hi = ph + 1; hipLaunchKernelGGL(mk_fwd, dim3(grid), dim3(512), LDS_BYTES, stream, p); }
#endif
#else
    p.ph_lo = 0; p.ph_hi = NPH;
    (void)hipMemsetAsync((unsigned char*)d_ws + WS_BAR, 0, 17 * 256, stream);
    void* args[] = {&p};
    hipError_t e = hipLaunchCooperativeKernel((const void*)mk_fwd, dim3(grid), dim3(512), args, LDS_BYTES, stream);
    if (e != hipSuccess) fprintf(stderr, "kernel_launch: cooperative launch failed: %s (grid %d)\n", hipGetErrorString(e), grid);
#endif
}
```

```cpp
#include <hip/hip_runtime.h>
#include <hip/hip_cooperative_groups.h>
#include <cstdio>
namespace cg = cooperative_groups;

#ifndef PROBE_DUP
#define PROBE_DUP 0
#endif
#ifndef PROBE_K2
#define PROBE_K2 0
#endif
#ifndef PROBE_EPI2
#define PROBE_EPI2 0
#endif
#ifndef PROBE_SYNC
#define PROBE_SYNC 0
#endif
#ifndef MK_MULTI
#define MK_MULTI 0
#endif

#define LAS __attribute__((address_space(3)))
typedef unsigned short bf16_t;
typedef short bf16x8 __attribute__((ext_vector_type(8)));
typedef float f32x4 __attribute__((ext_vector_type(4)));
typedef unsigned u32x4 __attribute__((ext_vector_type(4)));
typedef unsigned u32x2 __attribute__((ext_vector_type(2)));

constexpr int DM = 1024, SEQL = 4096, NP = 32768, NS = 128, NR = NP + NS, DFF = 2816;
constexpr int NPH = 15;
constexpr int LDS_BYTES = 131072 + 1024;
constexpr size_t O_YP = 0, O_YS = 33554432, O_KP = O_YS + 131072, O_VP = O_KP + 131072, O_CONVP = O_VP + 131072, O_POOLP = O_CONVP + 8192,
                 O_KS = O_POOLP + 122880, O_VS = O_KS + 16384, O_CONVS = O_VS + 16384, O_POOLS = O_CONVS + 8192;
constexpr size_t WS_X = 0;
constexpr size_t WS_XB = WS_X + (size_t)NR * DM * 4;
constexpr size_t WS_ACT = WS_XB + (size_t)NR * DM * 2;
constexpr size_t WS_Q = WS_ACT;
constexpr size_t WS_KB = WS_Q + (size_t)NR * 512 * 2;
constexpr size_t WS_VB = WS_KB + (size_t)NR * 128 * 2;
constexpr size_t WS_BG = WS_VB + (size_t)NR * 128 * 2;
constexpr size_t WS_U = WS_BG + (size_t)NR * 512 * 2;
constexpr size_t WS_MIX = WS_U + (size_t)NR * 512 * 2;
constexpr size_t WS_SS = WS_ACT + (size_t)NR * DFF * 2;
constexpr size_t WS_WGU = WS_SS + (size_t)NR * 16 * 4;
constexpr size_t WS_WD = WS_WGU + (size_t)4 * 5632 * 1024 * 2;
constexpr size_t WS_WIN = WS_WD + (size_t)4 * 1024 * 2816 * 2;
constexpr size_t WS_WOUT = WS_WIN + (size_t)2304 * 1024 * 2;
constexpr size_t WS_WP = WS_WOUT + (size_t)1024 * 1024 * 2;
constexpr size_t WS_BAR = WS_WP + (size_t)1024 * 256 * 2;
constexpr size_t WS_END = WS_BAR + 17 * 256;
static_assert(WS_MIX + (size_t)NR * 1024 * 2 == WS_SS, "mixer buffers alias ACT exactly");

struct Params {
    const float *x_prompt, *x_sample, *cache_k, *cache_v, *cache_conv, *cache_pool, *norm_g, *w_gate, *w_up, *w_down, *mix_w_in, *mix_w_out, *conv_w, *sinks, *rel_table, *pool_w, *pool_scale, *final_g;
    float* out; unsigned char* ws; int ph_lo, ph_hi;
};

__device__ __forceinline__ int bidx() { int b = (int)blockIdx.x; asm volatile("" : "+s"(b)); return b; }
typedef float f32x2_t __attribute__((ext_vector_type(2)));
typedef __bf16 bf16x2_t __attribute__((ext_vector_type(2)));
__device__ __forceinline__ unsigned cvt_pk_bf16(float lo, float hi) { const f32x2_t v = {lo, hi}; const bf16x2_t b = __builtin_convertvector(v, bf16x2_t); return __builtin_bit_cast(unsigned, b); }
__device__ __forceinline__ u32x2 pack4(f32x4 v) { u32x2 w; w.x = cvt_pk_bf16(v[0], v[1]); w.y = cvt_pk_bf16(v[2], v[3]); return w; }
__device__ __forceinline__ float bf_lo(unsigned w) { return __uint_as_float(w << 16); }
__device__ __forceinline__ float bf_hi(unsigned w) { return __uint_as_float(w & 0xffff0000u); }
__device__ __forceinline__ float row_rs(const float* SS, int row) {
    const f32x4* p = (const f32x4*)(SS + (size_t)row * 16); const f32x4 a = p[0], b = p[1], c = p[2], d = p[3];
    const f32x4 s = (a + b) + (c + d); const float t = (s[0] + s[1]) + (s[2] + s[3]);
    return __builtin_amdgcn_rsqf(t * (1.0f / 1024.0f) + 1e-6f);
}

namespace pg8 {
constexpr int BM = 256, BK = 64, HALF = 128, HTB = HALF * BK * 2, NXCD = 8, WGM = 8;
__device__ __forceinline__ int lds_byte(int r, int c) { const int st = (r >> 4) * 2 + (c >> 5), rr = r & 15, cc = c & 31, ob = rr * 64 + cc * 2; return st * 1024 + (ob ^ (((ob >> 9) & 1) << 5)); }
__device__ __forceinline__ void stage_rc(int b, int& R, int& C) { const int st = b / 1024, sb = b % 1024, swz = sb ^ (((sb >> 9) & 1) << 5); R = (st >> 1) * 16 + swz / 64; C = (st & 1) * 32 + (swz % 64) / 2; }
struct Unit { int pm, pn; };
struct Gemm { const bf16_t* A; const bf16_t* Bt; int nM, nN, K, lda, ldb, apn; };
struct StaticOrder {
    int nM, nN, nwg, G, c;
    __device__ void init(int nM_, int nN_, int G_, int c_) { nM = nM_; nN = nN_; nwg = nM * nN; G = G_; c = c_; }
    __device__ bool next(int i, Unit& u) const {
        const long L = (long)i * G + c; if (L >= nwg) return false;
        if (nM == 128) {
            const int xcd = (int)L & 7, off = (int)L >> 3, nig8 = 8 * nN, hi = off >= nig8, rem = off - (hi ? nig8 : 0);
            u.pm = (2 * xcd + hi) * 8 + (rem & 7); u.pn = rem >> 3; return true;
        }
        int wgid = (int)L; { const int q = nwg / NXCD, r = nwg % NXCD, xcd = wgid % NXCD, off = wgid / NXCD; wgid = (xcd < r ? xcd * (q + 1) : r * (q + 1) + (xcd - r) * q) + off; }
        const int nig = WGM * nN, gid = wgid / nig, fm = gid * WGM, gsz = (nM - fm) < WGM ? (nM - fm) : WGM;
        u.pm = fm + ((wgid % nig) % gsz); u.pn = (wgid % nig) / gsz; return true;
    }
};

template <class Epi>
__device__ __forceinline__ void gemm_phase(const int tid, LAS unsigned char* lds, const Gemm g, const StaticOrder& S, const Epi& E) {
    const int wid = __builtin_amdgcn_readfirstlane(tid >> 6), lane = tid & 63, wr = wid >> 2, wc = wid & 3, fr = lane & 15, fq = lane >> 4;
    const int K = g.K, nt = K / BK;
    unsigned voffA[2], voffB[2];
#pragma unroll
    for (int i = 0; i < 2; ++i) { int R, C; stage_rc(tid * 16 + i * 8192, R, C); voffA[i] = (unsigned)(R * g.lda + C) * 2u; voffB[i] = (unsigned)(R * g.ldb + C) * 2u; }
    const size_t kstep = (size_t)(BK * 2);
    const size_t hA = (size_t)HALF * g.lda * 2, hB = (size_t)HALF * g.ldb * 2;
    const unsigned ldsw = (unsigned)wid * 1024u;
    const int aoff = lds_byte(wr * 64 + fr, fq * 8), boff = lds_byte(wc * 32 + fr, fq * 8);
#define PG8_SA(b, h) (((b) * 2 + (h)) * HTB)
#define PG8_SB(b, h) ((4 + (b) * 2 + (h)) * HTB)
#define PG8_STAGE(bufoff, gbase, voff) do { _Pragma("unroll") for (int _i = 0; _i < 2; ++_i) \
        __builtin_amdgcn_global_load_lds((const unsigned*)((const char*)(gbase) + (voff)[_i]), (LAS unsigned*)(lds + (bufoff) + ldsw + _i * 8192), 16, 0, 0); } while (0)
#define PG8_LDA(dst, b, h) do { _Pragma("unroll") for (int m = 0; m < 4; ++m) _Pragma("unroll") for (int k = 0; k < 2; ++k) dst[m][k] = *(const LAS bf16x8*)(lds + PG8_SA(b, h) + aoff + m * 2048 + k * 1024); } while (0)
#define PG8_LDB(dst, b, h) do { _Pragma("unroll") for (int n = 0; n < 2; ++n) _Pragma("unroll") for (int k = 0; k < 2; ++k) dst[n][k] = *(const LAS bf16x8*)(lds + PG8_SB(b, h) + boff + n * 2048 + k * 1024); } while (0)
#define PG8_MMA(ai, bj, At, Bt) do { __builtin_amdgcn_s_setprio(1); _Pragma("unroll") for (int m = 0; m < 4; ++m) _Pragma("unroll") for (int n = 0; n < 2; ++n) _Pragma("unroll") for (int k = 0; k < 2; ++k) \
        acc[ai][bj][m][n] = __builtin_amdgcn_mfma_f32_16x16x32_bf16(Bt[n][k], At[m][k], acc[ai][bj][m][n], 0, 0, 0); __builtin_amdgcn_s_setprio(0); } while (0)
#define PG8_WAIT_V(n) asm volatile("s_waitcnt vmcnt(" #n ")" ::: "memory")
#define PG8_WAIT_L(n) asm volatile("s_waitcnt lgkmcnt(" #n ")" ::: "memory")
#define PG8_BAR __builtin_amdgcn_s_barrier()
#define PG8_SCHED __builtin_amdgcn_sched_barrier(0)
    Unit cur, nxt; int ui = 0, last_pm = -1; LAS float* rsl = (LAS float*)(lds + 131072);
    if (!S.next(0, cur)) return;
    f32x4 acc[2][2][4][2];
#pragma unroll
    for (int a = 0; a < 2; ++a)
#pragma unroll
        for (int b = 0; b < 2; ++b)
#pragma unroll
            for (int m = 0; m < 4; ++m)
#pragma unroll
                for (int n = 0; n < 2; ++n) acc[a][b][m][n] = (f32x4){0.f, 0.f, 0.f, 0.f};
    bf16x8 At[4][2], B0[2][2], B1[2][2];
    const char* cA = (const char*)g.A + ((size_t)cur.pm * 256 * g.lda + (size_t)cur.pn * g.apn) * 2; const char* cB = (const char*)g.Bt + (size_t)cur.pn * 256 * g.ldb * 2;
    PG8_STAGE(PG8_SB(0, 0), cB, voffB); PG8_STAGE(PG8_SA(0, 0), cA, voffA); PG8_STAGE(PG8_SB(0, 1), cB + hB, voffB); PG8_STAGE(PG8_SA(0, 1), cA + hA, voffA);
    if (wr == 1) PG8_BAR;
    PG8_WAIT_V(4); PG8_BAR;
    PG8_STAGE(PG8_SB(1, 0), cB + kstep, voffB); PG8_STAGE(PG8_SA(1, 0), cA + kstep, voffA); PG8_STAGE(PG8_SB(1, 1), cB + hB + kstep, voffB);
    PG8_WAIT_V(6); PG8_BAR;
    for (;;) {
        const bool has_next = S.next(PROBE_K2 ? ((ui + 1) >> 1) : (ui + 1), nxt);
        const char* nA = has_next ? (const char*)g.A + ((size_t)nxt.pm * 256 * g.lda + (size_t)nxt.pn * g.apn) * 2 : cA; const char* nB = has_next ? (const char*)g.Bt + (size_t)nxt.pn * 256 * g.ldb * 2 : cB;
        for (int t = 0; t < nt; t += 2) {
            const bool last = (t == nt - 2);
            const char* a1 = cA + (size_t)(t + 1) * kstep;
            const char* a2 = last ? nA : cA + (size_t)(t + 2) * kstep; const char* b2 = last ? nB : cB + (size_t)(t + 2) * kstep;
            const char* a3 = a2 + kstep; const char* b3 = b2 + kstep;
            PG8_LDB(B0, 0, 0); PG8_SCHED; PG8_LDA(At, 0, 0); PG8_STAGE(PG8_SA(1, 1), a1 + hA, voffA);
            PG8_WAIT_L(8); PG8_BAR; PG8_WAIT_L(0); PG8_MMA(0, 0, At, B0); PG8_BAR; PG8_SCHED;
            PG8_LDB(B1, 0, 1); PG8_STAGE(PG8_SB(0, 0), b2, voffB);
            PG8_BAR; PG8_WAIT_L(0); PG8_MMA(0, 1, At, B1); PG8_BAR;
            PG8_LDA(At, 0, 1); PG8_STAGE(PG8_SA(0, 0), a2, voffA);
            PG8_BAR; PG8_WAIT_L(0); PG8_MMA(1, 0, At, B0); PG8_BAR; PG8_SCHED;
            PG8_STAGE(PG8_SB(0, 1), b2 + hB, voffB);
            PG8_WAIT_V(6); PG8_BAR; PG8_MMA(1, 1, At, B1); PG8_BAR;
            PG8_LDB(B0, 1, 0); PG8_SCHED; PG8_LDA(At, 1, 0); PG8_STAGE(PG8_SA(0, 1), a2 + hA, voffA);
            PG8_WAIT_L(8); PG8_BAR; PG8_WAIT_L(0); PG8_MMA(0, 0, At, B0); PG8_BAR; PG8_SCHED;
            PG8_LDB(B1, 1, 1); PG8_STAGE(PG8_SB(1, 0), b3, voffB);
            PG8_BAR; PG8_WAIT_L(0); PG8_MMA(0, 1, At, B1); PG8_BAR;
            PG8_LDA(At, 1, 1); PG8_STAGE(PG8_SA(1, 0), a3, voffA);
            PG8_BAR; PG8_WAIT_L(0); PG8_MMA(1, 0, At, B0); PG8_BAR; PG8_SCHED;
            PG8_STAGE(PG8_SB(1, 1), b3 + hB, voffB);
            PG8_WAIT_V(6); PG8_BAR; PG8_MMA(1, 1, At, B1); PG8_BAR;
        }
        if (!PROBE_K2 || (ui & 1)) {
        if constexpr (Epi::NEEDS_RS) {
            if (cur.pm != last_pm) { last_pm = cur.pm;
                if (tid < 256) rsl[tid] = row_rs(E.SS, cur.pm * 256 + tid);
                PG8_WAIT_L(0); PG8_BAR; }
        }
        E(acc, cur, wr, wc, fr, fq, rsl);
        if constexpr (PROBE_EPI2 && Epi::NEEDS_RS) { asm volatile("" ::: "memory"); E(acc, cur, wr, wc, fr, fq, rsl); }
        }
        if (!has_next) break;
#pragma unroll
        for (int a = 0; a < 2; ++a)
#pragma unroll
            for (int b = 0; b < 2; ++b)
#pragma unroll
                for (int m = 0; m < 4; ++m)
#pragma unroll
                    for (int n = 0; n < 2; ++n) acc[a][b][m][n] = (f32x4){0.f, 0.f, 0.f, 0.f};
        cur = nxt; cA = nA; cB = nB; ++ui;
    }
    PG8_WAIT_V(0);
    if (wr == 0) PG8_BAR;
    PG8_BAR;
#undef PG8_SA
#undef PG8_SB
#undef PG8_STAGE
#undef PG8_LDA
#undef PG8_LDB
#undef PG8_MMA
#undef PG8_WAIT_V
#undef PG8_WAIT_L
#undef PG8_BAR
#undef PG8_SCHED
}
}

struct EpiSwiglu {
    static constexpr bool NEEDS_RS = true;
    const float* SS; bf16_t* ACT;
    __device__ __forceinline__ f32x4 act4(float rs, f32x4 g, f32x4 u) const {
        f32x4 a;
#pragma unroll
        for (int j = 0; j < 4; ++j) { const float gg = g[j] * rs, uu = u[j] * rs; a[j] = gg * __builtin_amdgcn_rcpf(1.0f + __expf(-gg)) * uu; }
        return a;
    }
    __device__ __forceinline__ void operator()(const f32x4 (&acc)[2][2][4][2], const pg8::Unit& u, int wr, int wc, int fr, int fq, const LAS float* rsl) const {
#pragma unroll
        for (int ai = 0; ai < 2; ++ai)
#pragma unroll
            for (int m = 0; m < 4; ++m) { const int lr = ai * 128 + wr * 64 + m * 16 + fr, row = u.pm * 256 + lr; const float rs = rsl[lr];
                const u32x2 lo = pack4(act4(rs, acc[ai][0][m][0], acc[ai][0][m][1])), hi = pack4(act4(rs, acc[ai][1][m][0], acc[ai][1][m][1]));
                *(u32x4*)(ACT + (size_t)row * DFF + u.pn * 128 + wc * 32 + 8 * fq) = (u32x4){lo.x, lo.y, hi.x, hi.y}; }
    }
    __device__ __forceinline__ void wtile(int row, int colbase, int fq, const f32x4 (&v)[2]) const {
        const int r = 128 * (colbase >> 8) + 32 * ((colbase >> 5) & 3) + 8 * fq + 4 * ((colbase >> 7) & 1);
        *(u32x2*)(ACT + (size_t)row * DFF + r) = pack4(act4(row_rs(SS, row), v[0], v[1]));
    }
};

__device__ __forceinline__ f32x4 unpack4(u32x2 w) { return (f32x4){bf_lo(w.x), bf_hi(w.x), bf_lo(w.y), bf_hi(w.y)}; }
struct EpiResid {
    static constexpr bool NEEDS_RS = false;
    bf16_t* XB; float* SS;
    __device__ __forceinline__ float oct(int row, int col, u32x4 r, f32x4 a0, f32x4 a1) const {
        const f32x4 x0 = unpack4((u32x2){r.x, r.y}) + a0, x1 = unpack4((u32x2){r.z, r.w}) + a1; const u32x2 p0 = pack4(x0), p1 = pack4(x1);
        *(u32x4*)(XB + (size_t)row * DM + col) = (u32x4){p0.x, p0.y, p1.x, p1.y};
        return ((x0[0] * x0[0] + x0[1] * x0[1]) + (x0[2] * x0[2] + x0[3] * x0[3])) + ((x1[0] * x1[0] + x1[1] * x1[1]) + (x1[2] * x1[2] + x1[3] * x1[3]));
    }
    __device__ __forceinline__ void ldres(u32x4 (&r)[2], const pg8::Unit& u, int g, int wr, int wc, int fr, int fq) const {
        const bf16_t* rp = XB + (size_t)(u.pm * 256 + (g >> 2) * 128 + wr * 64 + (g & 3) * 16 + fr) * DM + u.pn * 256 + wc * 32 + 8 * fq;
#pragma unroll
        for (int bj = 0; bj < 2; ++bj) r[bj] = *(const u32x4*)(rp + bj * 128);
    }
    __device__ __forceinline__ void operator()(const f32x4 (&acc)[2][2][4][2], const pg8::Unit& u, int wr, int wc, int fr, int fq, const LAS float*) const {
        u32x4 r[8][2];
#pragma unroll
        for (int g = 0; g < 6; ++g) ldres(r[g], u, g, wr, wc, fr, fq);
#pragma unroll
        for (int g = 0; g < 8; ++g) { const int ai = g >> 2, m = g & 3, row = u.pm * 256 + ai * 128 + wr * 64 + m * 16 + fr; float ss = 0.f;
#pragma unroll
            for (int bj = 0; bj < 2; ++bj) ss += oct(row, u.pn * 256 + bj * 128 + wc * 32 + 8 * fq, r[g][bj], acc[ai][bj][m][0], acc[ai][bj][m][1]);
            ss += __shfl_xor(ss, 16); ss += __shfl_xor(ss, 32);
            if (fq == 0) SS[(size_t)row * 16 + u.pn * 4 + wc] = ss;
            if (g + 6 < 8) ldres(r[g + 6], u, g + 6, wr, wc, fr, fq); }
    }
    __device__ __forceinline__ void wtile(int row, int colbase, int fq, const f32x4 (&v)[4]) const {
        const bf16_t* rp = XB + (size_t)row * DM + colbase + 8 * fq; u32x4 r[2];
#pragma unroll
        for (int h = 0; h < 2; ++h) r[h] = *(const u32x4*)(rp + 32 * h);
        float ss = oct(row, colbase + 8 * fq, r[0], v[0], v[1]) + oct(row, colbase + 32 + 8 * fq, r[1], v[2], v[3]);
        ss += __shfl_xor(ss, 16); ss += __shfl_xor(ss, 32);
        if (fq == 0) SS[(size_t)row * 16 + (colbase >> 6)] = ss;
    }
};

struct EpiMixIn {
    static constexpr bool NEEDS_RS = true;
    const float* SS; bf16_t *Q, *KB, *VB, *BG, *U; float* out;
    __device__ __forceinline__ void tile2(int row, int colbase, int fq, float rs, f32x4 v0, f32x4 v1) const {
        v0 = v0 * rs; v1 = v1 * rs;
        int b, s; const bool smp = row >= NP;
        if (!smp) { b = row >> 12; s = row & 4095; } else { b = (row - NP) >> 4; s = (row - NP) & 15; }
        if (colbase >= 1280) {
            const int c = ((colbase - 1280) >> 1) + 4 * fq; const f32x4 uu = v0 * v1;
            *(u32x2*)(U + (size_t)row * 512 + c) = pack4(uu);
            if (!smp) { if (s >= SEQL - 2) *(f32x4*)(out + O_CONVP + (size_t)(b * 2 + s - (SEQL - 2)) * 512 + c) = uu; }
            else { if (s >= 14) *(f32x4*)(out + O_CONVS + (size_t)(b * 2 + s - 14) * 512 + c) = uu; }
        } else {
            const int col = colbase + 8 * fq; const u32x2 w0 = pack4(v0), w1 = pack4(v1); const u32x4 w = (u32x4){w0.x, w0.y, w1.x, w1.y};
            if (colbase < 512) *(u32x4*)(Q + (size_t)row * 512 + col) = w;
            else if (colbase < 768) {
                const bool isk = colbase < 640; const int c = col - (isk ? 512 : 640);
                *(u32x4*)((isk ? KB : VB) + (size_t)row * 128 + c) = w;
                float* d = nullptr;
                if (!smp) { if (s >= SEQL - 128) d = out + (isk ? O_KP : O_VP) + (size_t)(b * 128 + s - (SEQL - 128)) * 128 + c; }
                else d = out + (isk ? O_KS : O_VS) + (size_t)(row - NP) * 128 + c;
                if (d) { *(f32x4*)d = v0; *(f32x4*)(d + 4) = v1; }
            } else *(u32x4*)(BG + (size_t)row * 512 + col - 768) = w;
        }
    }
    __device__ __forceinline__ void operator()(const f32x4 (&acc)[2][2][4][2], const pg8::Unit& u, int wr, int wc, int fr, int fq, const LAS float* rsl) const {
#pragma unroll
        for (int ai = 0; ai < 2; ++ai)
#pragma unroll
            for (int m = 0; m < 4; ++m) { const int lr = ai * 128 + wr * 64 + m * 16 + fr, row = u.pm * 256 + lr; const float rs = rsl[lr];
#pragma unroll
                for (int bj = 0; bj < 2; ++bj) tile2(row, u.pn * 256 + bj * 128 + wc * 32, fq, rs, acc[ai][bj][m][0], acc[ai][bj][m][1]); }
    }
    __device__ __forceinline__ void wtile(int row, int colbase, int fq, const f32x4 (&v)[2]) const { tile2(row, colbase, fq, row_rs(SS, row), v[0], v[1]); }
};

template <int NB, int UNR, class Epi>
__device__ __forceinline__ void sgemm(const bf16_t* A, int lda, const bf16_t* Bt, int ldb, int K, int N, const Epi& E, int gw, int nw, int fr, int fq) {
    const int ncb = N / (16 * NB);
    for (int it = gw; it < 8 * ncb; it += nw) {
        const int rb = it & 7, cb = it >> 3, col0 = cb * 16 * NB, row = NP + rb * 16 + fr;
        const bf16_t* ap = A + (size_t)row * lda + fq * 8;
        const bf16_t* bp = Bt + (size_t)(col0 + fr) * ldb + fq * 8;
        f32x4 acc[NB];
#pragma unroll
        for (int n = 0; n < NB; ++n) acc[n] = (f32x4){0.f, 0.f, 0.f, 0.f};
        for (int k = 0; k < K; k += 32 * UNR) {
            bf16x8 a[UNR], b[UNR][NB];
#pragma unroll
            for (int u = 0; u < UNR; ++u) { a[u] = *(const bf16x8*)(ap + k + 32 * u);
#pragma unroll
                for (int n = 0; n < NB; ++n) b[u][n] = *(const bf16x8*)(bp + (size_t)n * 16 * ldb + k + 32 * u); }
#pragma unroll
            for (int u = 0; u < UNR; ++u)
#pragma unroll
                for (int n = 0; n < NB; ++n) acc[n] = __builtin_amdgcn_mfma_f32_16x16x32_bf16(b[u][n], a[u], acc[n], 0, 0, 0);
        }
        E.wtile(row, col0, fq, acc);
    }
}
template <class Epi>
__device__ __forceinline__ void sgemm4_splitk(const int tid, LAS unsigned char* lds, const bf16_t* A, int lda, const bf16_t* Bt, int ldb, int K, int agrp, const Epi& E) {
    const int wave = __builtin_amdgcn_readfirstlane(tid >> 6), lane = tid & 63, fr = lane & 15, fq = lane >> 4, G = gridDim.x;
    for (int it = bidx(); it < 128; it += G) {
        const int rb = it & 7, cb = it >> 3, col0 = cb * 64, row = NP + rb * 16 + fr, kper = K >> 3, kbeg = wave * kper, kend = kbeg + kper;
        const bf16_t* ap = A + (size_t)row * lda + (agrp ? (col0 & ~255) : 0) + fq * 8;
        const bf16_t* bp = Bt + (size_t)(col0 + fr) * ldb + fq * 8;
        f32x4 acc[4];
#pragma unroll
        for (int n = 0; n < 4; ++n) acc[n] = (f32x4){0.f, 0.f, 0.f, 0.f};
        for (int k = kbeg; k < kend; k += 192) {
            bf16x8 a[6], b[6][4];
#pragma unroll
            for (int u = 0; u < 6; ++u) if (k + 32 * u < kend) { a[u] = *(const bf16x8*)(ap + k + 32 * u);
#pragma unroll
                for (int n = 0; n < 4; ++n) b[u][n] = *(const bf16x8*)(bp + (size_t)n * 16 * ldb + k + 32 * u); }
#pragma unroll
            for (int u = 0; u < 6; ++u) if (k + 32 * u < kend) {
#pragma unroll
                for (int n = 0; n < 4; ++n) acc[n] = __builtin_amdgcn_mfma_f32_16x16x32_bf16(b[u][n], a[u], acc[n], 0, 0, 0); }
        }
#pragma unroll
        for (int n = 0; n < 4; ++n) *(LAS f32x4*)(lds + wave * 4096 + n * 1024 + lane * 16) = acc[n];
        __syncthreads();
        if (wave == 0) {
#pragma unroll
            for (int n = 0; n < 4; ++n) { f32x4 t = acc[n];
#pragma unroll
                for (int w = 1; w < 8; ++w) t = t + *(const LAS f32x4*)(lds + w * 4096 + n * 1024 + lane * 16);
                acc[n] = t; }
            E.wtile(row, col0, fq, acc);
        }
        __syncthreads();
    }
}

struct WTile { const float* src0; const float* src1; const float* gp; const float* vs; bf16_t* dst; float cmul; int lds_src, ldd, k0, v0, kind; };
__device__ __forceinline__ WTile wtile_decode(const Params& p, int t) {
    constexpr int T_GU = 4 * 16 * 22, T_WD = 4 * 44 * 4, T_WIN = 16 * 9, T_WOUT = 16 * 4;
    WTile w; w.src1 = nullptr; w.gp = nullptr; w.vs = nullptr; w.cmul = 1.0f;
    if (t < T_GU) { const int f = t / (16 * 22), tt = t % (16 * 22); w.k0 = (tt / 22) * 64; w.v0 = (tt % 22) * 256; w.kind = 1;
        w.src0 = p.w_gate + (size_t)f * DM * DFF; w.src1 = p.w_up + (size_t)f * DM * DFF; w.gp = p.norm_g + ((f >> 1) * 3 + ((f & 1) ? 2 : 0)) * DM; w.lds_src = DFF; w.ldd = DM; w.dst = (bf16_t*)(p.ws + WS_WGU) + (size_t)f * 5632 * DM; }
    else if (t < T_GU + T_WD) { const int t2 = t - T_GU, f = t2 / (44 * 4), tt = t2 % (44 * 4); w.k0 = (tt / 4) * 64; w.v0 = (tt % 4) * 256; w.kind = 0;
        w.src0 = p.w_down + (size_t)f * DFF * DM; w.cmul = 0.5f; w.lds_src = DM; w.ldd = DFF; w.dst = (bf16_t*)(p.ws + WS_WD) + (size_t)f * DM * DFF; }
    else if (t < T_GU + T_WD + T_WIN) { const int tt = t - T_GU - T_WD; w.k0 = (tt / 9) * 64; w.v0 = (tt % 9) * 256; w.kind = 2;
        w.src0 = p.mix_w_in; w.gp = p.norm_g + 1 * DM; w.lds_src = 2304; w.ldd = DM; w.dst = (bf16_t*)(p.ws + WS_WIN); }
    else if (t < T_GU + T_WD + T_WIN + T_WOUT) { const int tt = t - T_GU - T_WD - T_WIN; w.k0 = (tt / 4) * 64; w.v0 = (tt % 4) * 256; w.kind = 0;
        w.src0 = p.mix_w_out; w.lds_src = DM; w.ldd = DM; w.dst = (bf16_t*)(p.ws + WS_WOUT); }
    else { const int t2 = t - T_GU - T_WD - T_WIN - T_WOUT, gi = t2 >> 2, tt = t2 & 3; w.k0 = tt * 64; w.v0 = 0; w.kind = 0;
        w.src0 = p.pool_w + (size_t)gi * 65536; w.vs = p.pool_scale + gi * 256; w.lds_src = 256; w.ldd = 256; w.dst = (bf16_t*)(p.ws + WS_WP) + (size_t)gi * 65536; }
    return w;
}
__device__ __forceinline__ void wtile_load(const WTile& w, int tid, f32x4 (&q)[8]) {
#pragma unroll
    for (int i = 0; i < 8; ++i) { const int e = tid + 512 * i, kr = e >> 6, v = w.v0 + (e & 63) * 4; const float* sp = w.src0; int col = v;
        if (w.kind == 1) { col = 128 * (v >> 8) + 32 * ((v >> 5) & 3) + 8 * ((v >> 2) & 3) + 4 * ((v >> 7) & 1); if ((v >> 4) & 1) sp = w.src1; }
        else if (w.kind == 2) { if (v >= 1280) { const int x = v - 1280, j = x >> 5, ii = x & 31; col = ii < 16 ? 1280 + 16 * j + ii : 1792 + 16 * j + ii - 16; }
                                else { const int rho = v & 31; col = (v & ~31) + 8 * ((rho & 15) >> 2) + 4 * (rho >> 4); } }
        if (w.kind == 0) { const int rho = v & 31; col = (v & ~31) + 8 * ((rho & 15) >> 2) + 4 * (rho >> 4); }
        q[i] = __builtin_nontemporal_load((const f32x4*)(sp + (size_t)(w.k0 + kr) * w.lds_src + col)); if (w.gp) q[i] = q[i] * w.gp[w.k0 + kr]; if (w.vs) q[i] = q[i] * *(const f32x4*)(w.vs + col); q[i] = q[i] * w.cmul; }
}
__device__ __forceinline__ int late_tile(int j) {
    if (j < 352) return 352 + j;
    if (j < 528) return 1408 + 176 + (j - 352);
    if (j < 880) return 704 + (j - 528);
    if (j < 1056) return 1408 + 352 + (j - 880);
    if (j < 1408) return 1056 + (j - 1056);
    if (j < 1584) return 1408 + 528 + (j - 1408);
    return 2320 + (j - 1584);
}
constexpr int LATE_MIXIN = 640, LATE_ATTN = 1120, LATE_ALL = 1600, PRO_EARLY = 736;
__device__ __forceinline__ int pro_tile(int q) {
    if (q < 352) return q;
    if (q < 528) return 1408 + (q - 352);
    if (q < 672) return 2112 + (q - 528);
    if (q < 736) return 2256 + (q - 672);
    return late_tile(LATE_ATTN + (q - PRO_EARLY));
}
__device__ __forceinline__ void convert_range(const int tid, const Params& p, LAS unsigned char* lds, int first, int end, int stride, bool late) {
    LAS float* T = (LAS float*)lds;
    if (first >= end) return;
    f32x4 q[8]; int i = first; WTile cur = wtile_decode(p, late ? late_tile(i) : pro_tile(i));
    wtile_load(cur, tid, q);
    for (; i < end; i += stride) {
        __syncthreads();
#pragma unroll
        for (int k = 0; k < 8; ++k) { const int e = tid + 512 * k, kr = e >> 6, vv = (e & 63) * 4;
            T[kr * 257 + vv] = q[k][0]; T[kr * 257 + vv + 1] = q[k][1]; T[kr * 257 + vv + 2] = q[k][2]; T[kr * 257 + vv + 3] = q[k][3]; }
        bf16_t* dst = cur.dst; const int ldd = cur.ldd, k0 = cur.k0, v0 = cur.v0;
        if (i + stride < end) { cur = wtile_decode(p, late ? late_tile(i + stride) : pro_tile(i + stride)); wtile_load(cur, tid, q); }
        __syncthreads();
#pragma unroll
        for (int k = 0; k < 4; ++k) { const int e = tid + 512 * k, kq = (e & 7) * 8, vv = e >> 3;
            u32x4 wv; wv.x = cvt_pk_bf16(T[kq * 257 + vv], T[(kq + 1) * 257 + vv]); wv.y = cvt_pk_bf16(T[(kq + 2) * 257 + vv], T[(kq + 3) * 257 + vv]);
            wv.z = cvt_pk_bf16(T[(kq + 4) * 257 + vv], T[(kq + 5) * 257 + vv]); wv.w = cvt_pk_bf16(T[(kq + 6) * 257 + vv], T[(kq + 7) * 257 + vv]);
            *(u32x4*)(dst + (size_t)(v0 + vv) * ldd + k0 + kq) = wv; }
    }
}
__device__ __forceinline__ void prologue_phase(const int tid, const Params& p, LAS unsigned char* lds) {
    const int G = gridDim.x;
    convert_range(tid, p, lds, (int)bidx(), PRO_EARLY + (LATE_ALL - LATE_ATTN), G, false);
    const int lane = tid & 63, gw = (tid >> 6) * G + bidx(), nw = 8 * G;
    bf16_t* XB = (bf16_t*)(p.ws + WS_XB); float* SS = (float*)(p.ws + WS_SS);
    for (int r0 = gw; r0 < NR; r0 += 4 * nw) {
        f32x4 x[4][4];
#pragma unroll
        for (int r = 0; r < 4; ++r) { const int row = r0 + r * nw; if (row < NR) { const float* xp = row < NP ? p.x_prompt + (size_t)row * DM : p.x_sample + (size_t)(row - NP) * DM;
#pragma unroll
            for (int j = 0; j < 4; ++j) x[r][j] = __builtin_nontemporal_load((const f32x4*)(xp + lane * 8 + 512 * (j >> 1) + 4 * (j & 1))); } }
#pragma unroll
        for (int r = 0; r < 4; ++r) { const int row = r0 + r * nw; if (row < NR) { float ss = 0.f;
#pragma unroll
            for (int j = 0; j < 4; ++j) { const f32x4 v = x[r][j]; ss += (v[0] * v[0] + v[1] * v[1]) + (v[2] * v[2] + v[3] * v[3]); }
#pragma unroll
            for (int h = 0; h < 2; ++h) { const u32x2 a = pack4(x[r][2 * h]), b2 = pack4(x[r][2 * h + 1]); *(u32x4*)(XB + (size_t)row * DM + lane * 8 + 512 * h) = (u32x4){a.x, a.y, b2.x, b2.y}; }
#pragma unroll
            for (int o = 32; o >= 1; o >>= 1) ss += __shfl_xor(ss, o);
            if (lane < 16) SS[(size_t)row * 16 + lane] = lane == 0 ? ss : 0.f; } }
    }
}

__device__ __forceinline__ void attn_phase(const int tid, const Params& p, LAS unsigned char* lds) {
    LAS bf16_t* Ks = (LAS bf16_t*)lds;
    LAS bf16_t* Vt = (LAS bf16_t*)(lds + 27648);
    LAS float* TB = (LAS float*)(lds + 53248);
    const int wave = __builtin_amdgcn_readfirstlane(tid >> 6), lane = tid & 63, fr = lane & 15, fq = lane >> 4, G = gridDim.x;
    const bf16_t* Q = (const bf16_t*)(p.ws + WS_Q); const bf16_t* KB = (const bf16_t*)(p.ws + WS_KB); const bf16_t* VB = (const bf16_t*)(p.ws + WS_VB);
    const bf16_t* BG = (const bf16_t*)(p.ws + WS_BG); const bf16_t* U = (const bf16_t*)(p.ws + WS_U); bf16_t* MIX = (bf16_t*)(p.ws + WS_MIX);
    for (int i = tid; i < 8 * 256; i += 512) { const int h = i >> 8, rel = (i & 255) - 191, n = rel < 0 ? -rel : rel;
        int bk = n; if (n >= 8) { bk = 2 + (31 - __clz(n * n)); bk = bk > 15 ? 15 : bk; }
        bk += rel > 0 ? 16 : 0; TB[i] = p.rel_table[bk * 8 + h]; }
    for (int item = bidx(); item < 1040; item += G) {
        const bool smp = item >= 1024; int b, kvh, rowbase, kk_lo, kk_hi;
        if (!smp) { kvh = item & 1; const int c = (item >> 1) & 63; b = item >> 7; rowbase = b * SEQL + c * 64; kk_lo = 128 - c * 64; kk_lo = kk_lo < 0 ? 0 : kk_lo; kk_hi = 192; }
        else { const int i2 = item - 1024; kvh = i2 & 1; b = i2 >> 1; rowbase = NP + b * 16; kk_lo = 0; kk_hi = 144; }
        const int nunits = smp ? 4 : 16;
        bf16x8 qn[2];
        if (wave < nunits) { const int g0 = smp ? wave : (wave >> 2), qb0 = smp ? 0 : (wave & 3); const size_t qr0 = (size_t)rowbase + qb0 * 16 + fr;
#pragma unroll
            for (int ks = 0; ks < 2; ++ks) qn[ks] = *(const bf16x8*)(Q + qr0 * 512 + (kvh * 4 + g0) * 64 + ks * 32 + fq * 8); }
        const bool full = (kk_lo == 0 && kk_hi == 192);
        __syncthreads();
        u32x4 kvr[3], vvr[3];
#pragma unroll
        for (int it = 0; it < 3; ++it) { const int ch = tid + 512 * it, kk = ch >> 3, d8 = (ch & 7) * 8; u32x4 kv = (u32x4){0u, 0u, 0u, 0u}, vv = kv;
            if (kk >= kk_lo && kk < kk_hi) {
                if (smp && kk < 128) { const size_t o = ((size_t)(b * 128 + kk) * 2 + kvh) * 64 + d8;
                    const f32x4 k0 = *(const f32x4*)(p.cache_k + o), k1 = *(const f32x4*)(p.cache_k + o + 4), w0 = *(const f32x4*)(p.cache_v + o), w1 = *(const f32x4*)(p.cache_v + o + 4);
                    const u32x2 a = pack4(k0), bb = pack4(k1), c = pack4(w0), d = pack4(w1); kv = (u32x4){a.x, a.y, bb.x, bb.y}; vv = (u32x4){c.x, c.y, d.x, d.y}; }
                else { const size_t row = smp ? (size_t)(rowbase + kk - 128) : (size_t)(rowbase - 128 + kk);
                    kv = *(const u32x4*)(KB + row * 128 + kvh * 64 + d8); vv = *(const u32x4*)(VB + row * 128 + kvh * 64 + d8); } }
            kvr[it] = kv; vvr[it] = vv; }
#pragma unroll
        for (int it = 0; it < 3; ++it) { const int ch = tid + 512 * it, kk = ch >> 3, d8 = (ch & 7) * 8; const u32x4 kv = kvr[it], vv = vvr[it];
            *(LAS u32x4*)(Ks + kk * 72 + d8) = kv;
            Vt[(d8 + 0) * 200 + kk] = (bf16_t)(vv.x & 0xffffu); Vt[(d8 + 1) * 200 + kk] = (bf16_t)(vv.x >> 16);
            Vt[(d8 + 2) * 200 + kk] = (bf16_t)(vv.y & 0xffffu); Vt[(d8 + 3) * 200 + kk] = (bf16_t)(vv.y >> 16);
            Vt[(d8 + 4) * 200 + kk] = (bf16_t)(vv.z & 0xffffu); Vt[(d8 + 5) * 200 + kk] = (bf16_t)(vv.z >> 16);
            Vt[(d8 + 6) * 200 + kk] = (bf16_t)(vv.w & 0xffffu); Vt[(d8 + 7) * 200 + kk] = (bf16_t)(vv.w >> 16); }
        __syncthreads();
        for (int un = wave; un < nunits; un += 8) {
            const int g = smp ? un : (un >> 2), qb = smp ? 0 : (un & 3), head = kvh * 4 + g, qi = qb * 16 + fr; const size_t qrow = (size_t)rowbase + qi;
            bf16x8 qf[2]; qf[0] = qn[0]; qf[1] = qn[1];
            if (un + 8 < nunits) { const int un2 = un + 8, g2 = un2 >> 2, qb2 = un2 & 3; const size_t qr2 = (size_t)rowbase + qb2 * 16 + fr;
#pragma unroll
                for (int ks = 0; ks < 2; ++ks) qn[ks] = *(const bf16x8*)(Q + qr2 * 512 + (kvh * 4 + g2) * 64 + ks * 32 + fq * 8); }
            f32x4 s[12];
#pragma unroll
            for (int kb = 0; kb < 12; ++kb) { s[kb] = (f32x4){0.f, 0.f, 0.f, 0.f};
#pragma unroll
                for (int ks = 0; ks < 2; ++ks) { const bf16x8 a = *(const LAS bf16x8*)(Ks + (kb * 16 + fr) * 72 + ks * 32 + fq * 8); s[kb] = __builtin_amdgcn_mfma_f32_16x16x32_bf16(a, qf[ks], s[kb], 0, 0, 0); } }
            const float sink = p.sinks[head]; float mx = sink;
#pragma unroll
            for (int kb = 0; kb < 12; ++kb)
#pragma unroll
                for (int j = 0; j < 4; ++j) { const int kk = kb * 16 + 4 * fq + j; float v = s[kb][j] * 0.125f + TB[head * 256 + kk - 128 - qi + 191];
                    if (!full && (kk < kk_lo || kk >= kk_hi)) v = -1e30f; s[kb][j] = v; mx = fmaxf(mx, v); }
            mx = fmaxf(mx, __shfl_xor(mx, 16)); mx = fmaxf(mx, __shfl_xor(mx, 32));
            float sum = 0.f;
#pragma unroll
            for (int kb = 0; kb < 12; ++kb)
#pragma unroll
                for (int j = 0; j < 4; ++j) { const float e = __expf(s[kb][j] - mx); s[kb][j] = e; sum += e; }
            sum += __shfl_xor(sum, 16); sum += __shfl_xor(sum, 32);
            const float inv = 1.0f / (sum + __expf(sink - mx));
            bf16x8 pf[6];
#pragma unroll
            for (int k2 = 0; k2 < 6; ++k2) { const u32x2 a = pack4(s[2 * k2] * inv), c = pack4(s[2 * k2 + 1] * inv); const u32x4 w = (u32x4){a.x, a.y, c.x, c.y}; pf[k2] = __builtin_bit_cast(bf16x8, w); }
            int zv = 0; asm volatile("" : "+v"(zv));
#pragma unroll
            for (int db = 0; db < 4; ++db) { f32x4 o = (f32x4){0.f, 0.f, 0.f, 0.f};
#pragma unroll
                for (int k2 = 0; k2 < 6; ++k2) { const LAS bf16_t* vp = Vt + (db * 16 + fr) * 200 + 32 * k2 + 4 * fq + zv; const u32x2 a0 = *(const LAS u32x2*)vp, a1 = *(const LAS u32x2*)(vp + 16);
                    const u32x4 w = (u32x4){a0.x, a0.y, a1.x, a1.y}; o = __builtin_amdgcn_mfma_f32_16x16x32_bf16(__builtin_bit_cast(bf16x8, w), pf[k2], o, 0, 0, 0); }
                *(u32x2*)(MIX + qrow * 1024 + head * 64 + db * 16 + 4 * fq) = pack4(o); }
        }
    }
    {
        const int c = (tid & 63) * 8, rsub = tid >> 6, nrb = NR / 8;
        float w0[8], w1[8], w2[8];
#pragma unroll
        for (int j = 0; j < 8; ++j) { w0[j] = p.conv_w[c + j]; w1[j] = p.conv_w[512 + c + j]; w2[j] = p.conv_w[1024 + c + j]; }
        for (int rb0 = bidx(); rb0 < nrb; rb0 += 4 * G) {
            u32x4 a0[4], a1[4], a2[4], ab[4]; bool ok[4];
#pragma unroll
            for (int r = 0; r < 4; ++r) { const int rb = rb0 + r * G; ok[r] = rb < nrb; if (ok[r]) { const int row = rb * 8 + rsub; const bool smp = row >= NP; const int s1 = smp ? ((row - NP) & 15) : (row & 4095);
                a0[r] = *(const u32x4*)(U + (size_t)row * 512 + c); ab[r] = *(const u32x4*)(BG + (size_t)row * 512 + c);
                if (s1 >= 1) a1[r] = *(const u32x4*)(U + (size_t)(row - 1) * 512 + c);
                if (s1 >= 2) a2[r] = *(const u32x4*)(U + (size_t)(row - 2) * 512 + c); } }
#pragma unroll
            for (int r = 0; r < 4; ++r) if (ok[r]) { const int row = (rb0 + r * G) * 8 + rsub; const bool smp = row >= NP; int b, s1; if (!smp) { b = row >> 12; s1 = row & 4095; } else { b = (row - NP) >> 4; s1 = (row - NP) & 15; }
                float u0[8], u1[8], u2[8], bg[8];
                { const u32x4 w = a0[r]; u0[0] = bf_lo(w.x); u0[1] = bf_hi(w.x); u0[2] = bf_lo(w.y); u0[3] = bf_hi(w.y); u0[4] = bf_lo(w.z); u0[5] = bf_hi(w.z); u0[6] = bf_lo(w.w); u0[7] = bf_hi(w.w); }
                { const u32x4 w = ab[r]; bg[0] = bf_lo(w.x); bg[1] = bf_hi(w.x); bg[2] = bf_lo(w.y); bg[3] = bf_hi(w.y); bg[4] = bf_lo(w.z); bg[5] = bf_hi(w.z); bg[6] = bf_lo(w.w); bg[7] = bf_hi(w.w); }
                if (s1 >= 1) { const u32x4 w = a1[r]; u1[0] = bf_lo(w.x); u1[1] = bf_hi(w.x); u1[2] = bf_lo(w.y); u1[3] = bf_hi(w.y); u1[4] = bf_lo(w.z); u1[5] = bf_hi(w.z); u1[6] = bf_lo(w.w); u1[7] = bf_hi(w.w); }
                else {
#pragma unroll
                    for (int j = 0; j < 8; ++j) u1[j] = smp ? p.cache_conv[(size_t)(b * 2 + 1) * 512 + c + j] : 0.f; }
                if (s1 >= 2) { const u32x4 w = a2[r]; u2[0] = bf_lo(w.x); u2[1] = bf_hi(w.x); u2[2] = bf_lo(w.y); u2[3] = bf_hi(w.y); u2[4] = bf_lo(w.z); u2[5] = bf_hi(w.z); u2[6] = bf_lo(w.w); u2[7] = bf_hi(w.w); }
                else {
#pragma unroll
                    for (int j = 0; j < 8; ++j) u2[j] = smp ? p.cache_conv[(size_t)(b * 2 + s1) * 512 + c + j] : 0.f; }
                float y[8];
#pragma unroll
                for (int j = 0; j < 8; ++j) y[j] = bg[j] * (w0[j] * u2[j] + w1[j] * u1[j] + w2[j] * u0[j]);
                u32x4 w; w.x = cvt_pk_bf16(y[0], y[1]); w.y = cvt_pk_bf16(y[2], y[3]); w.z = cvt_pk_bf16(y[4], y[5]); w.w = cvt_pk_bf16(y[6], y[7]);
                *(u32x4*)(MIX + (size_t)row * 1024 + 512 + c) = w; }
        }
    }
    { const int nx = 1040 % G, cw = (int)bidx(); if (cw >= nx) convert_range(tid, p, lds, LATE_MIXIN + cw - nx, LATE_ATTN, G - nx, true); }
}

struct F8 { f32x4 a, b; };
__device__ __forceinline__ F8 pool_h8(const Params& p, const bf16_t* X, const LAS float* rsl, bool smp, int b, int seqrow0, int t0, int t, int col, f32x4 ga, f32x4 gb) {
    F8 h;
    if (t < 0) { if (!smp) { h.a = (f32x4){0.f, 0.f, 0.f, 0.f}; h.b = h.a; return h; }
        const float* cp = p.cache_pool + (size_t)(b * 15 + 15 + t) * DM + col; h.a = *(const f32x4*)cp; h.b = *(const f32x4*)(cp + 4); return h; }
    const float r = rsl[t - t0 + 16]; const u32x4 w = *(const u32x4*)(X + (size_t)(seqrow0 + t) * DM + col);
    h.a = unpack4((u32x2){w.x, w.y}) * r * ga; h.b = unpack4((u32x2){w.z, w.w}) * r * gb; return h;
}
__device__ __forceinline__ void pooldiff_phase(const int tid, const Params& p, LAS unsigned char* lds) {
    LAS float* RS = (LAS float*)lds;
    const int quarter = tid >> 7, tl = tid & 127, G = gridDim.x;
    const bf16_t* X = (const bf16_t*)(p.ws + WS_XB); const float* SS = (const float*)(p.ws + WS_SS); bf16_t* D = (bf16_t*)(p.ws + WS_MIX);
    const int col = tl * 8, w = 2 << (col >> 8);
    const f32x4 ga = *(const f32x4*)(p.norm_g + 4 * DM + col), gb = *(const f32x4*)(p.norm_g + 4 * DM + col + 4); const float invw = 1.0f / (float)w;
    for (int item = bidx(); item < 256 + 2; item += G) {
        const bool smp = item >= 256; int b, t0, nrows, seqrow0, T0;
        if (!smp) { const int blk = item * 4 + quarter; b = blk >> 7; t0 = (blk & 127) * 32; nrows = 32; seqrow0 = b * SEQL; T0 = 0; }
        else { b = (item - 256) * 4 + quarter; t0 = 0; nrows = 16; seqrow0 = NP + b * 16; T0 = 1024; }
        __syncthreads();
        if (tl < 48) { const int t = t0 - 16 + tl; if (t >= 0 && t < t0 + nrows) RS[quarter * 48 + tl] = row_rs(SS, seqrow0 + t); }
        __syncthreads();
        const LAS float* rsl = RS + quarter * 48;
        f32x4 spa = (f32x4){0.f, 0.f, 0.f, 0.f}, spb = spa;
#pragma unroll
        for (int j = 1; j < 16; ++j) if (j < w) { const F8 h = pool_h8(p, X, rsl, smp, b, seqrow0, t0, t0 - j, col, ga, gb); spa = spa + h.a; spb = spb + h.b; }
        for (int tb = t0; tb < t0 + nrows; tb += 4) {
            F8 h4[4], o4[4];
#pragma unroll
            for (int j = 0; j < 4; ++j) { h4[j] = pool_h8(p, X, rsl, smp, b, seqrow0, t0, tb + j, col, ga, gb); o4[j] = pool_h8(p, X, rsl, smp, b, seqrow0, t0, tb + j - w + 1, col, ga, gb); }
#pragma unroll
            for (int j = 0; j < 4; ++j) { const int t = tb + j; const f32x4 ha = h4[j].a, hb = h4[j].b; const f32x4 sa = spa + ha, sb = spb + hb;
                const int cnt = (T0 + t + 1) < w ? (T0 + t + 1) : w; const float ic = cnt == w ? invw : 1.0f / (float)cnt;
                const u32x2 da = pack4(sa * ic - ha), db = pack4(sb * ic - hb);
                *(u32x4*)(D + (size_t)(seqrow0 + t) * DM + col) = (u32x4){da.x, da.y, db.x, db.y};
                spa = sa - o4[j].a; spb = sb - o4[j].b;
                float* po = nullptr;
                if (!smp) { if (t >= SEQL - 15) po = p.out + O_POOLP + (size_t)(b * 15 + t - (SEQL - 15)) * DM + col; }
                else { if (t >= 1) po = p.out + O_POOLS + (size_t)(b * 15 + t - 1) * DM + col; }
                if (po) { *(f32x4*)po = ha; *(f32x4*)(po + 4) = hb; } }
        }
    }
}

__device__ __forceinline__ void final_phase(const int tid, const Params& p) {
    const int lane = tid & 63, G = gridDim.x, gw = (tid >> 6) * G + bidx(), nw = 8 * G;
    const bf16_t* X = (const bf16_t*)(p.ws + WS_XB); const float* SS = (const float*)(p.ws + WS_SS);
    f32x4 g[4];
#pragma unroll
    for (int j = 0; j < 4; ++j) g[j] = *(const f32x4*)(p.final_g + lane * 4 + 256 * j);
    for (int r0 = gw; r0 < NR; r0 += 4 * nw) {
        f32x4 x[4][4]; float rs[4];
#pragma unroll
        for (int r = 0; r < 4; ++r) { const int row = r0 + r * nw; if (row < NR) { rs[r] = row_rs(SS, row);
#pragma unroll
            for (int j = 0; j < 4; ++j) x[r][j] = unpack4(*(const u32x2*)(X + (size_t)row * DM + lane * 4 + 256 * j)); } }
#pragma unroll
        for (int r = 0; r < 4; ++r) { const int row = r0 + r * nw; if (row < NR) { float* dst = row < NP ? p.out + O_YP + (size_t)row * DM : p.out + O_YS + (size_t)(row - NP) * DM;
#pragma unroll
            for (int j = 0; j < 4; ++j) __builtin_nontemporal_store(x[r][j] * rs[r] * g[j], (f32x4*)(dst + lane * 4 + 256 * j)); } }
    }
}

__device__ __forceinline__ void grid_bar(unsigned* bar, unsigned k) {
    asm volatile("s_waitcnt vmcnt(0)" ::: "memory");
    __syncthreads();
    if (threadIdx.x == 0) {
        const unsigned g = bidx() & 7u, per = (gridDim.x + 7u - g) >> 3, ngrp = gridDim.x < 8u ? gridDim.x : 8u;
        __builtin_amdgcn_fence(__ATOMIC_RELEASE, "agent");
        asm volatile("s_waitcnt vmcnt(0)" ::: "memory");
        const unsigned old = __hip_atomic_fetch_add(bar + 64 * g, 1u, __ATOMIC_RELAXED, __HIP_MEMORY_SCOPE_AGENT);
        if (old + 1u == per * k) {
            const unsigned ot = __hip_atomic_fetch_add(bar + 64 * 8, 1u, __ATOMIC_RELAXED, __HIP_MEMORY_SCOPE_AGENT);
            if (ot + 1u == ngrp * k) {
#pragma unroll
                for (int j = 0; j < 8; ++j) __hip_atomic_store(bar + 64 * (9 + j), k, __ATOMIC_RELAXED, __HIP_MEMORY_SCOPE_AGENT);
            }
        }
        while (__hip_atomic_load(bar + 64 * (9 + g), __ATOMIC_RELAXED, __HIP_MEMORY_SCOPE_AGENT) < k) __builtin_amdgcn_s_sleep(1);
        __builtin_amdgcn_fence(__ATOMIC_ACQUIRE, "agent");
        asm volatile("s_waitcnt vmcnt(0)" ::: "memory");
    }
    __syncthreads();
}

enum { K_PRO = 0, K_G1, K_RES, K_MIXIN, K_ATTN, K_PDIFF, K_FINAL, K_DUMP };
#ifndef DBG_LAST
#define DBG_LAST -1
#endif
__device__ __forceinline__ void dump_phase(const int tid, const Params& p) {
    const int G = gridDim.x; const size_t gt = (size_t)bidx() * 512 + tid, nt = (size_t)G * 512;
    const bf16_t* XB = (const bf16_t*)(p.ws + WS_XB); const float* SS = (const float*)(p.ws + WS_SS);
#if DBG_LAST == 3 || DBG_LAST == 4
    const bf16_t* AR = (const bf16_t*)(p.ws + WS_ACT);
    for (size_t i = gt; i < (size_t)NR * DM; i += nt) { float v = __uint_as_float((unsigned)AR[i] << 16) + __uint_as_float((unsigned)AR[i + (size_t)NR * DM] << 16); if (i < (size_t)NR * 768) v += __uint_as_float((unsigned)AR[i + (size_t)2 * NR * DM] << 16); p.out[i] = v; }
#else
    for (size_t i = gt; i < (size_t)NR * DM; i += nt) { const int row = (int)(i >> 10); p.out[i] = __uint_as_float((unsigned)XB[i] << 16) * row_rs(SS, row); }
#endif
    for (size_t i = (size_t)NR * DM + gt; i < O_POOLS + 122880; i += nt) p.out[i] = 0.f;
}
__global__ void __launch_bounds__(512, 2) mk_fwd(Params pk) {
    extern __shared__ __attribute__((aligned(16))) unsigned char smem[];
    LAS unsigned char* lds = (LAS unsigned char*)smem;
    const int G = gridDim.x;
    unsigned nbar = 0;
    if (pk.ph_lo < 0) cg::this_grid().sync();
    for (int ph = pk.ph_lo; ph < pk.ph_hi; ++ph)
    for (int rep = 0; rep < 1 + ((PROBE_DUP >> ph) & 1); ++rep) {
        int tid = threadIdx.x; asm volatile("" : "+v"(tid));
        Params p = pk; { size_t z = 0; asm volatile("" : "+s"(z)); p.ws = pk.ws + z; p.out = pk.out + z; }
        bf16_t* XB = (bf16_t*)(p.ws + WS_XB); float* SS = (float*)(p.ws + WS_SS); bf16_t* ACT = (bf16_t*)(p.ws + WS_ACT); bf16_t* MIX = (bf16_t*)(p.ws + WS_MIX);
        int kind, f = 0;
        switch (ph) {
            case 0: kind = K_PRO; break;
            case 1: kind = K_G1; f = 0; break;   case 2: kind = K_RES; f = 0; break;
            case 3: kind = K_MIXIN; break;       case 4: kind = K_ATTN; break;       case 5: kind = K_RES; f = 4; break;
            case 6: kind = K_G1; f = 1; break;   case 7: kind = K_RES; f = 1; break;
            case 8: kind = K_G1; f = 2; break;   case 9: kind = K_RES; f = 2; break;
            case 10: kind = K_PDIFF; break;      case 11: kind = K_RES; f = 5; break;
            case 12: kind = K_G1; f = 3; break;  case 13: kind = K_RES; f = 3; break;
            case 14: kind = K_FINAL; break;
            default: kind = K_DUMP; break;
        }
        if (kind == K_PRO) prologue_phase(tid, p, lds);
        else if (kind == K_G1) {
            const bf16_t* W = (const bf16_t*)(p.ws + WS_WGU) + (size_t)f * 5632 * DM;
            EpiSwiglu E{SS, ACT};
            { const int lane = tid & 63; sgemm<2, 4>(XB, DM, W, DM, DM, 5632, E, __builtin_amdgcn_readfirstlane(tid >> 6) * G + bidx(), 8 * G, lane & 15, lane >> 4); }
            pg8::Gemm g{XB, W, 128, 22, DM, DM, DM, 0}; pg8::StaticOrder S; S.init(128, 22, G, (int)bidx());
            pg8::gemm_phase(tid, lds, g, S, E);
        } else if (kind == K_RES) {
            pg8::Gemm g; EpiResid E; E.XB = XB; E.SS = SS; int K, agrp = 0;
            if (f < 4) { g = pg8::Gemm{ACT, (const bf16_t*)(p.ws + WS_WD) + (size_t)f * DM * DFF, 128, 4, DFF, DFF, DFF, 0}; K = DFF; }
            else if (f == 4) { g = pg8::Gemm{MIX, (const bf16_t*)(p.ws + WS_WOUT), 128, 4, DM, DM, DM, 0}; K = DM; }
            else { g = pg8::Gemm{MIX, (const bf16_t*)(p.ws + WS_WP), 128, 4, 256, DM, 256, 256}; K = 256; agrp = 1; }
            sgemm4_splitk(tid, lds, g.A, g.lda, g.Bt, g.ldb, K, agrp, E);
            pg8::StaticOrder S; S.init(128, 4, G, (int)bidx());
            pg8::gemm_phase(tid, lds, g, S, E);
        } else if (kind == K_MIXIN) {
            const bf16_t* W = (const bf16_t*)(p.ws + WS_WIN);
            EpiMixIn E{SS, (bf16_t*)(p.ws + WS_Q), (bf16_t*)(p.ws + WS_KB), (bf16_t*)(p.ws + WS_VB), (bf16_t*)(p.ws + WS_BG), (bf16_t*)(p.ws + WS_U), p.out};
            { const int lane = tid & 63; sgemm<2, 4>(XB, DM, W, DM, DM, 2304, E, __builtin_amdgcn_readfirstlane(tid >> 6) * G + bidx(), 8 * G, lane & 15, lane >> 4); }
            pg8::Gemm g{XB, W, 128, 9, DM, DM, DM, 0}; pg8::StaticOrder S; S.init(128, 9, G, (int)bidx());
            pg8::gemm_phase(tid, lds, g, S, E);
            { const int nx = 1152 % G, c = (int)bidx(); if (c >= nx) convert_range(tid, p, lds, c - nx, LATE_MIXIN, G - nx, true); }
        } else if (kind == K_ATTN) attn_phase(tid, p, lds);
        else if (kind == K_PDIFF) pooldiff_phase(tid, p, lds);
        else if (kind == K_DUMP) dump_phase(tid, p);
        else final_phase(tid, p);
        if (ph + 1 < pk.ph_hi || rep < ((PROBE_DUP >> ph) & 1)) { grid_bar((unsigned*)(pk.ws + WS_BAR), nbar + 1);
            if (PROBE_SYNC) { ++nbar; grid_bar((unsigned*)(pk.ws + WS_BAR), nbar + 1); ++nbar; grid_bar((unsigned*)(pk.ws + WS_BAR), nbar + 1); }
            ++nbar; }
    }
}

extern "C" void kernel_launch(void* const* d_in, const int* in_sizes, int n_in, void* d_out, int out_size, void* d_ws, size_t ws_size, hipStream_t stream) {
    static int grid = 0;
    if (grid == 0) {
        if (ws_size < WS_END) { fprintf(stderr, "kernel_launch: workspace too small: %zu < %zu\n", ws_size, (size_t)WS_END); grid = -1; return; }
        if (hipFuncSetAttribute((const void*)mk_fwd, hipFuncAttributeMaxDynamicSharedMemorySize, LDS_BYTES) != hipSuccess) { fprintf(stderr, "kernel_launch: hipFuncSetAttribute failed\n"); grid = -1; return; }
        int dev = 0, cus = 0, per_cu = 0;
        (void)hipGetDevice(&dev); (void)hipDeviceGetAttribute(&cus, hipDeviceAttributeMultiprocessorCount, dev);
        (void)hipOccupancyMaxActiveBlocksPerMultiprocessor(&per_cu, (const void*)mk_fwd, 512, LDS_BYTES);
        if (per_cu < 1) { fprintf(stderr, "kernel_launch: occupancy query says %d blocks per CU\n", per_cu); per_cu = 1; }
        (void)hipGetLastError();
        grid = cus;
    }
    if (grid < 0) return;
    Params p{};
    p.x_prompt = (const float*)d_in[0]; p.x_sample = (const float*)d_in[1]; p.cache_k = (const float*)d_in[2]; p.cache_v = (const float*)d_in[3]; p.cache_conv = (const float*)d_in[4]; p.cache_pool = (const float*)d_in[5];
    p.norm_g = (const float*)d_in[6]; p.w_gate = (const float*)d_in[7]; p.w_up = (const float*)d_in[8]; p.w_down = (const float*)d_in[9]; p.mix_w_in = (const float*)d_in[10]; p.mix_w_out = (const float*)d_in[11];
    p.conv_w = (const float*)d_in[12]; p.sinks = (const float*)d_in[13]; p.rel_table = (const float*)d_in[14]; p.pool_w = (const float*)d_in[15]; p.pool_scale = (const float*)d_in[16]; p.final_g = (const float*)d_in[17];
    p.out = (float*)d_out; p.ws = (unsigned char*)d_ws;
#if MK_MULTI
#if DBG_LAST >= 0
    for (int ph = 0; ph <= DBG_LAST; ++ph) { p.ph_lo = ph; p.ph_hi = ph + 1; hipLaunchKernelGGL(mk_fwd, dim3(grid), dim3(512), LDS_BYTES, stream, p); }
    p.ph_lo = 15; p.ph_hi = 16; hipLaunchKernelGGL(mk_fwd, dim3(grid), dim3(512), LDS_BYTES, stream, p);
#else
    for (int ph = 0; ph < NPH; ++ph) { p.ph_lo = ph; p.ph_hi = ph + 1; hipLaunchKernelGGL(mk_fwd, dim3(grid), dim3(512), LDS_BYTES, stream, p); }
#endif
#else
    p.ph_lo = 0; p.ph_hi = NPH;
    (void)hipMemsetAsync((unsigned char*)d_ws + WS_BAR, 0, 17 * 256, stream);
    void* args[] = {&p};
    hipError_t e = hipLaunchCooperativeKernel((const void*)mk_fwd, dim3(grid), dim3(512), args, LDS_BYTES, stream);
    if (e != hipSuccess) fprintf(stderr, "kernel_launch: cooperative launch failed: %s (grid %d)\n", hipGetErrorString(e), grid);
#endif
}
```
